# Optimizing an MI355X kernel written in HIP

```python
import jax
import jax.numpy as jnp
from jax import lax
import numpy as np


D_MODEL = 2048
BATCH = 1
SEQ = 16384
DEPTH = 4

GRID_W = 64
CTX_LEN = 256
HEAD_DIM = 128
CONV_W = D_MODEL // 4
FOURIER_GROUPS = D_MODEL // 512
FOURIER_W = FOURIER_GROUPS * HEAD_DIM
NA_HEADS = D_MODEL // 512
NA_W = NA_HEADS * HEAD_DIM
NA_ROWS = 8
NA_COLS = 16
GQA_Q_HEADS = D_MODEL // 256
GQA_KV_HEADS = GQA_Q_HEADS // 4
GQA_GROUP = GQA_Q_HEADS // GQA_KV_HEADS
GQA_W = GQA_Q_HEADS * HEAD_DIM
GQA_KV_W = GQA_KV_HEADS * HEAD_DIM
Q_BLOCK = 128
N_BRANCH = 4
_SA = 3 * CONV_W
_SF = _SA + FOURIER_W
_SN = _SF + 3 * NA_W
_SQ = _SN + GQA_W
_SK = _SQ + GQA_KV_W
IN_SPLITS = (_SA, _SF, _SN, _SQ, _SK)
N_IN = _SK + GQA_KV_W
D_FF = 11 * D_MODEL // 4
ROPE_THETA = 10000.0
EPS = 1e-6

kernel_name = 'hybrid_parallel_conv_fourier_natten_gqa_dit'


def rms_norm(x, gain):
    xf = x.astype(jnp.float32)
    y = xf * lax.rsqrt(jnp.mean(xf * xf, axis=-1, keepdims=True) + EPS)
    return y.astype(x.dtype) * gain


def modulate(x, shift, scale):
    return x * (1.0 + scale) + shift


def ada_mod(cvec, w, b):
    return jnp.split(jax.nn.silu(cvec) @ w + b, 6, axis=-1)


def dwconv3(x, w):
    xp = jnp.pad(x, ((0, 0), (1, 1), (0, 0)))
    return xp[:, :-2] * w[0] + xp[:, 1:-1] * w[1] + xp[:, 2:] * w[2]


def to_heads(z, n_heads):
    return z.reshape(z.shape[0], z.shape[1], n_heads, HEAD_DIM)


def qk_norm(z, n_heads, gain):
    return rms_norm(to_heads(z, n_heads), gain)


def axial_rope(n_tok, dtype):
    t = jnp.arange(n_tok)
    row = (t // GRID_W).astype(jnp.float32)
    col = (t % GRID_W).astype(jnp.float32)
    n_freq = HEAD_DIM // 4
    inv_freq = ROPE_THETA ** (-jnp.arange(n_freq, dtype=jnp.float32) / n_freq)
    ang = jnp.concatenate([row[:, None] * inv_freq, col[:, None] * inv_freq], axis=-1)
    return jnp.cos(ang).astype(dtype)[None, :, None, :], jnp.sin(ang).astype(dtype)[None, :, None, :]


def apply_rope(x, cos, sin):
    x1, x2 = jnp.split(x, 2, axis=-1)
    return jnp.concatenate([x1 * cos - x2 * sin, x1 * sin + x2 * cos], axis=-1)


def short_conv_mixer(z, w):
    xa, bg, cg = jnp.split(z, 3, axis=-1)
    return bg * dwconv3(cg * xa, w)


def fourier_mixer(z):
    b, t, _ = z.shape
    g = z.reshape(b, t, FOURIER_GROUPS, HEAD_DIM).astype(jnp.float32)
    f = jnp.fft.fftn(g, axes=(1, 3), norm='ortho').real
    return f.reshape(b, t, FOURIER_W).astype(z.dtype)


def dense_attention(q, k, v):
    b, l, hq, dh = q.shape
    hkv = k.shape[2]
    qg = q.reshape(b, l, hkv, hq // hkv, dh)
    s = jnp.einsum('bqhgd,bkhd->bhgqk', qg, k).astype(jnp.float32) * (dh ** -0.5)
    p = jax.nn.softmax(s, axis=-1).astype(v.dtype)
    return jnp.einsum('bhgqk,bkhd->bqhgd', p, v).reshape(b, l, hq * dh)


def gqa_latent_attention(q, k, v, kc, vc):
    b, s_len, hq, dh = q.shape
    k_all = jnp.concatenate([k, kc], axis=1)
    v_all = jnp.concatenate([v, vc], axis=1)
    n_blk = s_len // Q_BLOCK
    qb = q.reshape(b, n_blk, Q_BLOCK, GQA_KV_HEADS, GQA_GROUP, dh).transpose(1, 0, 2, 3, 4, 5)
    scale = dh ** -0.5

    def block(q_blk):
        s = jnp.einsum('bqhgd,bkhd->bhgqk', q_blk, k_all).astype(jnp.float32) * scale
        p = jax.nn.softmax(s, axis=-1).astype(v_all.dtype)
        return jnp.einsum('bhgqk,bkhd->bqhgd', p, v_all)

    o = lax.map(block, qb)
    return o.transpose(1, 0, 2, 3, 4, 5).reshape(b, s_len, hq * dh)


def neighborhood_attention(q, k, v, kc, vc, rpb):
    b, s_len, h, dh = q.shape
    rows = s_len // GRID_W
    kr = min(NA_ROWS, rows)
    qg = q.reshape(b, rows, GRID_W, h, dh)
    kg = k.reshape(b, rows, GRID_W, h, dh)
    vg = v.reshape(b, rows, GRID_W, h, dh)
    col = jnp.arange(GRID_W)
    col_idx = jnp.clip(col - NA_COLS // 2, 0, GRID_W - NA_COLS)[:, None] + jnp.arange(NA_COLS)[None, :]
    dc_idx = col_idx - col[:, None] + NA_COLS - 1
    n_nb = kr * NA_COLS
    scale = dh ** -0.5

    def row_block(r):
        r0 = jnp.clip(r - kr // 2, 0, rows - kr)
        k_nb = lax.dynamic_slice_in_dim(kg, r0, kr, axis=1)[:, :, col_idx]
        v_nb = lax.dynamic_slice_in_dim(vg, r0, kr, axis=1)[:, :, col_idx]
        q_r = lax.dynamic_index_in_dim(qg, r, axis=1, keepdims=False)
        dr_idx = r0 + jnp.arange(kr) - r + NA_ROWS - 1
        bias = rpb[:, dr_idx][:, :, dc_idx].transpose(0, 2, 1, 3)
        s_nb = jnp.einsum('bqhd,brqchd->bhqrc', q_r, k_nb).astype(jnp.float32) * scale + bias.astype(jnp.float32)
        s_ctx = jnp.einsum('bqhd,bkhd->bhqk', q_r, kc).astype(jnp.float32) * scale
        s = jnp.concatenate([s_nb.reshape(b, h, GRID_W, n_nb), s_ctx], axis=-1)
        p = jax.nn.softmax(s, axis=-1).astype(v.dtype)
        p_nb = p[..., :n_nb].reshape(b, h, GRID_W, kr, NA_COLS)
        p_ctx = p[..., n_nb:]
        return (jnp.einsum('bhqrc,brqchd->bqhd', p_nb, v_nb)
                + jnp.einsum('bhqk,bkhd->bqhd', p_ctx, vc))

    o = lax.map(row_block, jnp.arange(rows))
    return o.transpose(1, 0, 2, 3, 4).reshape(b, s_len, h * dh)


def merge_branches(xn, ys, w_outs, w_gate, b_gate, w_o):
    g = jnp.split(jax.nn.sigmoid(xn @ w_gate + b_gate), N_BRANCH, axis=-1)
    merged = (g[0] * (ys[0] @ w_outs[0]) + g[1] * (ys[1] @ w_outs[1])
              + g[2] * (ys[2] @ w_outs[2]) + g[3] * (ys[3] @ w_outs[3]))
    return merged @ w_o


def conv_ffn(xn, w_up, conv_w, w_down):
    u = dwconv3(xn @ w_up, conv_w)
    a, gate = jnp.split(u, 2, axis=-1)
    return (jax.nn.silu(a) * gate) @ w_down


def setup_inputs(seed: int = 0) -> dict:
    key = jax.random.key(seed)
    keys = jax.random.split(key, 32)
    counter = [0]

    def nrm(shape, scale):
        k = keys[counter[0]]
        counter[0] += 1
        return jax.random.normal(k, shape, jnp.float32) * scale

    def gain(shape):
        return 1.0 + nrm(shape, 0.02)

    L = DEPTH
    D = D_MODEL
    return {
        'x': nrm((BATCH, SEQ, D), 1.0),
        'c': nrm((BATCH, D), 1.0),
        'ctx': nrm((BATCH, CTX_LEN, D), 1.0),
        'c_ctx': nrm((D,), 1.0),
        'w_ada': nrm((L, D, 6 * D), 0.5 * D ** -0.5),
        'b_ada': nrm((L, 6 * D), 0.01),
        'norm1': gain((L, D)),
        'w_in': nrm((L, D, N_IN), D ** -0.5),
        'conv_w': nrm((L, 3, CONV_W), 3 ** -0.5),
        'na_q_gain': gain((L, HEAD_DIM)),
        'na_k_gain': gain((L, HEAD_DIM)),
        'na_rpb': nrm((L, NA_HEADS, 2 * NA_ROWS - 1, 2 * NA_COLS - 1), 0.1),
        'gqa_q_gain': gain((L, HEAD_DIM)),
        'gqa_k_gain': gain((L, HEAD_DIM)),
        'w_conv_out': nrm((L, CONV_W, D), CONV_W ** -0.5),
        'w_fourier_out': nrm((L, FOURIER_W, D), FOURIER_W ** -0.5),
        'w_na_out': nrm((L, NA_W, D), NA_W ** -0.5),
        'w_gqa_out': nrm((L, GQA_W, D), GQA_W ** -0.5),
        'w_gate': nrm((L, D, N_BRANCH * D), D ** -0.5),
        'b_gate': nrm((L, N_BRANCH * D), 0.01),
        'w_o': nrm((L, D, D), D ** -0.5),
        'norm2': gain((L, D)),
        'w_up': nrm((L, D, 2 * D_FF), D ** -0.5),
        'ffn_conv_w': nrm((L, 3, 2 * D_FF), 3 ** -0.5),
        'w_down': nrm((L, D_FF, D), D_FF ** -0.5),
    }


def reference(x, c, ctx, c_ctx, w_ada, b_ada, norm1, w_in, conv_w, na_q_gain, na_k_gain, na_rpb,
              gqa_q_gain, gqa_k_gain, w_conv_out, w_fourier_out, w_na_out, w_gqa_out, w_gate, b_gate,
              w_o, norm2, w_up, ffn_conv_w, w_down):
    h = x
    hc = ctx
    cos, sin = axial_rope(x.shape[1], x.dtype)
    c_lat = c[:, None, :]
    for i in range(DEPTH):
        last = i == DEPTH - 1
        sh1, sc1, g1, sh2, sc2, g2 = ada_mod(c_lat, w_ada[i], b_ada[i])
        csh1, csc1, cg1, csh2, csc2, cg2 = ada_mod(c_ctx, w_ada[i], b_ada[i])
        xn = modulate(rms_norm(h, norm1[i]), sh1, sc1)
        xcn = modulate(rms_norm(hc, norm1[i]), csh1, csc1)
        za, zf, zn, zq, zk, zv = jnp.split(xn @ w_in[i], IN_SPLITS, axis=-1)
        cza, czf, czn, czq, czk, czv = jnp.split(xcn @ w_in[i], IN_SPLITS, axis=-1)
        nq_raw, nk_raw, nv_raw = jnp.split(zn, 3, axis=-1)
        cnq_raw, cnk_raw, cnv_raw = jnp.split(czn, 3, axis=-1)
        nq = qk_norm(nq_raw, NA_HEADS, na_q_gain[i])
        nk = qk_norm(nk_raw, NA_HEADS, na_k_gain[i])
        nv = to_heads(nv_raw, NA_HEADS)
        cnk = qk_norm(cnk_raw, NA_HEADS, na_k_gain[i])
        cnv = to_heads(cnv_raw, NA_HEADS)
        gq = apply_rope(qk_norm(zq, GQA_Q_HEADS, gqa_q_gain[i]), cos, sin)
        gk = apply_rope(qk_norm(zk, GQA_KV_HEADS, gqa_k_gain[i]), cos, sin)
        gv = to_heads(zv, GQA_KV_HEADS)
        ck = qk_norm(czk, GQA_KV_HEADS, gqa_k_gain[i])
        cv = to_heads(czv, GQA_KV_HEADS)
        merge_w = (w_conv_out[i], w_fourier_out[i], w_na_out[i], w_gqa_out[i])
        ys = (short_conv_mixer(za, conv_w[i]),
              fourier_mixer(zf),
              neighborhood_attention(nq, nk, nv, cnk, cnv, na_rpb[i]),
              gqa_latent_attention(gq, gk, gv, ck, cv))
        h = h + g1 * merge_branches(xn, ys, merge_w, w_gate[i], b_gate[i], w_o[i])
        h = h + g2 * conv_ffn(modulate(rms_norm(h, norm2[i]), sh2, sc2), w_up[i], ffn_conv_w[i], w_down[i])
        if not last:
            cnq = qk_norm(cnq_raw, NA_HEADS, na_q_gain[i])
            cq = qk_norm(czq, GQA_Q_HEADS, gqa_q_gain[i])
            cys = (short_conv_mixer(cza, conv_w[i]),
                   fourier_mixer(czf),
                   dense_attention(cnq, cnk, cnv),
                   dense_attention(cq, ck, cv))
            hc = hc + cg1 * merge_branches(xcn, cys, merge_w, w_gate[i], b_gate[i], w_o[i])
            hc = hc + cg2 * conv_ffn(modulate(rms_norm(hc, norm2[i]), csh2, csc2), w_up[i], ffn_conv_w[i], w_down[i])
    return h
```

```cpp
#include <hip/hip_runtime.h>
#include <cstdio>
#include <cstdint>

#ifndef PROBE_DUP
#define PROBE_DUP (-1)
#endif
#define PROBE_REP(i) for (int rep_ = 0; rep_ < ((PROBE_DUP == (i)) ? 2 : 1); ++rep_)
#define PROBE_END() do { if (PROBE_DUP >= 0) __syncthreads(); } while (0)
#ifndef MK_PER_PHASE
#define MK_PER_PHASE 0
#endif

#define LAS __attribute__((address_space(3)))
#define GAS __attribute__((address_space(1)))
typedef unsigned short bf16_t;
typedef short bf16x8 __attribute__((ext_vector_type(8)));
typedef short s16x4 __attribute__((ext_vector_type(4)));
typedef float f32x2 __attribute__((ext_vector_type(2)));
typedef float f32x4 __attribute__((ext_vector_type(4)));
typedef float f32x16 __attribute__((ext_vector_type(16)));
typedef unsigned u32x2 __attribute__((ext_vector_type(2)));
typedef unsigned u32x4 __attribute__((ext_vector_type(4)));

constexpr int D = 2048, SEQ = 16384, CTXL = 256, MT = SEQ + CTXL, DEPTH = 4;
constexpr int ZLD = 4608;
constexpr int YLD = 2560;
constexpr int PLD = 8192;
constexpr int ULD = 11264, FF = 5632, NIN = 5120, NADA = 12288;
constexpr float EPS = 1e-6f;
constexpr float GATE_PRESCALE = -1.4426950408889634f;
constexpr float QK_PRESCALE = 0.088388347648318440f * 1.4426950408889634f;
constexpr int NWAVES = 8;

constexpr size_t MiB = 1u << 20;
constexpr size_t WS_CTL = 0, CTL_ZERO_BYTES = 1 * MiB;
constexpr size_t WS_D1 = 1 * MiB;
constexpr size_t WS_DCT = WS_D1 + 128 * 1024;
constexpr size_t WS_DCTX = WS_DCT + 1 * MiB;
constexpr size_t WS_TW = WS_DCTX + 256 * 1024;
constexpr size_t WS_RT = WS_TW + 128 * 1024;
constexpr size_t WS_CT = WS_RT + 64 * 1024;
constexpr size_t WS_MOD = 3 * MiB;
constexpr size_t WS_ADAP = 4 * MiB;
constexpr size_t WS_HC = 16 * MiB;
constexpr size_t WS_XTC = 18 * MiB;
constexpr size_t WS_W = 20 * MiB;
constexpr size_t WL_IN = 0;
constexpr size_t WL_FT = WL_IN + (size_t)4608 * 2048 * 2;
constexpr size_t WL_INF = WL_IN + (size_t)5632 * 2048 * 2;
constexpr size_t WL_GATE = WL_INF + (size_t)2048 * 512 * 2;
constexpr size_t WL_O = WL_GATE + (size_t)8192 * 2048 * 2;
constexpr size_t WL_UP = WL_O + (size_t)2048 * 2048 * 2;
constexpr size_t WL_DOWN = WL_UP + (size_t)11264 * 2048 * 2;
constexpr size_t WL_OUT = WL_DOWN + (size_t)2048 * 5632 * 2;
constexpr size_t WL_STRIDE = WL_OUT + (size_t)2048 * 2560 * 2;
constexpr size_t WS_XN = WS_W + 4 * WL_STRIDE;
constexpr size_t WS_Z = WS_XN + (size_t)MT * D * 2;
constexpr size_t WS_XT = WS_Z + (size_t)MT * ZLD * 2;
constexpr size_t WS_YT = WS_XT + (size_t)65536 * 256 * 2;
constexpr size_t WS_YS = WS_YT + (size_t)65536 * 256 * 2;
constexpr size_t WS_P = WS_YS + (size_t)MT * YLD * 2;
constexpr size_t WS_ACT = WS_Z;
constexpr size_t WS_MG = WS_P + (size_t)MT * PLD * 2;
constexpr size_t WS_HB = WS_MG + (size_t)MT * D * 2;
constexpr size_t WS_PWO = WS_HB + (size_t)SEQ * D * 2;
constexpr size_t WS_PDN = WS_PWO + (size_t)8 * 256 * 2048 * 4;
constexpr size_t WS_GC = WS_PDN + (size_t)11 * 256 * 2048 * 4;
constexpr size_t WS_PUP = WS_GC + (size_t)256 * 8192 * 2;
constexpr size_t WS_SB = WS_PUP + (size_t)4 * 256 * ULD * 4;
constexpr size_t WS_END = WS_SB + (size_t)64 * 4 * ULD * 4 + MiB;
static_assert(WS_ACT + (size_t)MT * FF * 2 <= WS_YS, "ACT overlay");
static_assert(WL_STRIDE % 256 == 0 && WS_XN % 256 == 0, "align");
constexpr int CW_BAR = 4096;
constexpr int CW_TEAM = 8192, NSTEP = 3;
enum { ST_NORM1 = 0, ST_NORM2 = 1, ST_CONV = 2 };
static_assert((CW_TEAM + 4 * NSTEP * 65 * 64) * 4 <= (int)CTL_ZERO_BYTES, "counters inside the memset region");

constexpr int RING_BYTES = 131072, LDSCTL_OFF = RING_BYTES, MISC_OFF = LDSCTL_OFF + 320, PTAB_OFF = LDSCTL_OFF + 512, HALO_OFF = LDSCTL_OFF + 2048  , LDS_BYTES = 147456;

#define LDS_WAIT() asm volatile("s_waitcnt lgkmcnt(0)" ::: "memory")
#define VM_WAIT() asm volatile("s_waitcnt vmcnt(0)" ::: "memory")
__device__ __forceinline__ unsigned cvt_pk_bf16(float lo, float hi) { unsigned r; asm("v_cvt_pk_bf16_f32 %0, %1, %2" : "=v"(r) : "v"(lo), "v"(hi)); return r; }
__device__ __forceinline__ float bf_lo(unsigned w) { return __uint_as_float(w << 16); }
__device__ __forceinline__ float bf_hi(unsigned w) { return __uint_as_float(w & 0xffff0000u); }
template <class T> __device__ __forceinline__ void st_off(void* base, unsigned off, T v) { *(GAS T*)((GAS char*)base + off) = v; }
template <class T> __device__ __forceinline__ T ld_off(const void* base, unsigned off) { return *(const GAS T*)((const GAS char*)base + off); }
__device__ __forceinline__ float shfl_xor_l(float v, int lane, int o) { return __int_as_float(__builtin_amdgcn_ds_bpermute((lane ^ o) << 2, __float_as_int(v))); }
__device__ __forceinline__ float wave_sum(float v, int lane) {
#pragma unroll
    for (int o = 1; o < 64; o <<= 1) v += shfl_xor_l(v, lane, o);
    return v;
}

#define XB_TMO      128
#define XB_XCNT(j)  (256  + 64 * (j))
#define XB_XSUB(j)  (1280 + 64 * (j))
#define XB_XGEN(j)  (2304 + 64 * (j))
#define XB_TOP      3328
#define XB_TOPGEN   3392
#define XCD_BAR_WORDS 3456
#define XB_SPIN_CAP (1u << 18)
__device__ __forceinline__ unsigned xb_ld(unsigned* p)              { return __hip_atomic_load(p, __ATOMIC_RELAXED, __HIP_MEMORY_SCOPE_AGENT); }
__device__ __forceinline__ unsigned xb_add(unsigned* p, unsigned v) { return __hip_atomic_fetch_add(p, v, __ATOMIC_RELAXED, __HIP_MEMORY_SCOPE_AGENT); }
__device__ __forceinline__ unsigned xb_xcc_id() { return (unsigned)__builtin_amdgcn_s_getreg((3 << 11) | 20) & 0xFu; }
#define XB_SPIN(cond, bar) do { unsigned _sp = 0; while (cond) { __builtin_amdgcn_s_sleep(1); \
    if ((++_sp & 255u) == 0u) { if (xb_ld(&(bar)[XB_TMO])) break; if (_sp > XB_SPIN_CAP) { atomicAdd(&(bar)[XB_TMO], 1u); break; } } } } while (0)
struct XcdBarrier { unsigned* bar; unsigned x; volatile LAS unsigned* st; };
__device__ __forceinline__ XcdBarrier xcd_barrier_post(unsigned* bar, volatile LAS unsigned* st) {
    XcdBarrier b; b.bar = bar; b.x = xb_xcc_id(); b.st = st;
    if (threadIdx.x == 0) (void)xb_add(&bar[XB_XCNT(b.x)], 1u);
    return b;
}
__device__ __forceinline__ void xcd_barrier_complete(unsigned* bar, unsigned x, unsigned& nloc, unsigned& nx) {
    const unsigned G = gridDim.x * gridDim.y * gridDim.z;
    unsigned sum, cnt, mine, sp = 0u;
    for (;;) {
        sum = 0u; cnt = 0u; mine = 0u;
#pragma unroll
        for (unsigned j = 0; j < 16; ++j) { const unsigned c = xb_ld(&bar[XB_XCNT(j)]); sum += c; cnt += (c > 0u) ? 1u : 0u; mine = (j == x) ? c : mine; }
        if (sum == G) break;
        __builtin_amdgcn_s_sleep(1);
        if ((++sp & 255u) == 0u) { if (xb_ld(&bar[XB_TMO])) break; if (sp > XB_SPIN_CAP) { atomicAdd(&bar[XB_TMO], 1u); break; } }
    }
    nloc = mine > 0u ? mine : 1u; nx = cnt > 0u ? cnt : 1u;
}
__device__ __forceinline__ void xcd_barrier(const XcdBarrier& b) {
    asm volatile("s_waitcnt vmcnt(0)" ::: "memory");
    __syncthreads();
    if (threadIdx.x == 0) {
        unsigned* bar = b.bar;
        __builtin_amdgcn_s_waitcnt(0);
        unsigned nloc = b.st[0], nx = b.st[1];
        if (nloc == 0u) { xcd_barrier_complete(bar, b.x, nloc, nx); b.st[0] = nloc; b.st[1] = nx; }
        const unsigned old = xb_add(&bar[XB_XSUB(b.x)], 1u);
        const unsigned gen = old / nloc;
        if (old + 1u == (gen + 1u) * nloc) {
            __builtin_amdgcn_fence(__ATOMIC_RELEASE, "agent");
            asm volatile("s_waitcnt vmcnt(0)" ::: "memory");
            const unsigned og = xb_add(&bar[XB_TOP], 1u);
            const unsigned tg = og / nx;
            if (og + 1u == (tg + 1u) * nx) xb_add(&bar[XB_TOPGEN], 1u);
            else XB_SPIN(xb_ld(&bar[XB_TOPGEN]) == tg, bar);
            __builtin_amdgcn_fence(__ATOMIC_ACQUIRE, "agent");
            xb_add(&bar[XB_XGEN(b.x)], 1u);
            asm volatile("s_waitcnt vmcnt(0)" ::: "memory");
        } else {
            XB_SPIN(xb_ld(&bar[XB_XGEN(b.x)]) == gen, bar);
            __builtin_amdgcn_fence(__ATOMIC_ACQUIRE, "agent");
            asm volatile("s_waitcnt vmcnt(0)" ::: "memory");
        }
    }
    __syncthreads();
}

__device__ __forceinline__ void team_arrive(unsigned* w1, unsigned* w2) {
    asm volatile("s_waitcnt vmcnt(0)" ::: "memory"); __syncthreads();
    if (threadIdx.x == 0) { (void)xb_add(w1, 1u); (void)xb_add(w2, 1u); }
}
__device__ __forceinline__ void team_wait(unsigned* w, unsigned need, unsigned* tmo) {
    if (threadIdx.x == 0) { unsigned sp = 0u;
        while (xb_ld(w) < need) { __builtin_amdgcn_s_sleep(1); if ((++sp & 255u) == 0u) { if (xb_ld(tmo)) break; if (sp > XB_SPIN_CAP) { atomicAdd(tmo, 1u); break; } } }
        __builtin_amdgcn_fence(__ATOMIC_ACQUIRE, "agent"); asm volatile("s_waitcnt vmcnt(0)" ::: "memory"); }
    __syncthreads();
}

namespace pg8 {
constexpr int BM = 256, BK = 64, HALF = 128, HTB = HALF * BK * 2, STAGE_BYTES = 8 * HTB, NXCD = 8, WGM = 8;
__host__ __device__ __forceinline__ int lds_byte(int r, int c) { const int st = (r >> 4) * 2 + (c >> 5), rr = r & 15, cc = c & 31, ob = rr * 64 + cc * 2; return st * 1024 + (ob ^ (((ob >> 9) & 1) << 5)); }
__host__ __device__ __forceinline__ void stage_rc(int b, int& R, int& C) { const int st = b / 1024, sb = b % 1024, swz = sb ^ (((sb >> 9) & 1) << 5); R = (st >> 1) * 16 + swz / 64; C = (st & 1) * 32 + (swz % 64) / 2; }
__host__ __device__ __forceinline__ int perm32(int rho) { const int n = rho >> 4, i = rho & 15; return 8 * (i >> 2) + 4 * n + (i & 3); }
struct Unit { int pm, pn; };
struct StaticOrder {
    int nM, nN, nwg, G, c;
    __device__ __forceinline__ void init(int nM_, int nN_, int G_, int c_) { nM = nM_; nN = nN_; nwg = nM * nN; G = G_; c = c_; }
    __device__ __forceinline__ bool next(int i, Unit& u) const {
        const long L = (long)i * G + c; if (L >= nwg) return false;
        int wgid = (int)L; { const int q = nwg / NXCD, r = nwg % NXCD, xcd = wgid % NXCD, off = wgid / NXCD; wgid = (xcd < r ? xcd * (q + 1) : r * (q + 1) + (xcd - r) * q) + off; }
        const int nig = WGM * nN, gid = wgid / nig, fm = gid * WGM, gsz = (nM - fm) < WGM ? (nM - fm) : WGM;
        u.pm = fm + ((wgid % nig) % gsz); u.pn = (wgid % nig) / gsz; return true;
    }
};
struct ProbPlain {
    const char* A; const char* B; int lda, ldb; long hA, hB, tA, tB; int nt; long kB;
    __device__ __forceinline__ void locate(const Unit& u, const char*& cA, const char*& cB, int& n) const { cA = A + (long)u.pm * tA; cB = B + (long)u.pn * tB + (long)u.pm * kB; n = nt; }
};
struct ProbOut {
    const char* A; const char* B; int lda, ldb; long hA, hB, tA, tB;
    __device__ __forceinline__ void locate(const Unit& u, const char*& cA, const char*& cB, int& n) const {
        const int b = u.pn >> 3; const long koff = (long)b * 512 * 2;
        cA = A + (long)u.pm * tA + koff; cB = B + (long)(u.pn & 7) * tB + koff; n = (b == 3) ? 16 : 8; }
};
struct ProbFold {
    const char* A; const char* B; int lda, ldb; long hA, hB, tA, tB; long lB;
    __device__ __forceinline__ void locate(const Unit& u, const char*& cA, const char*& cB, int& n) const { cA = A + (long)(u.pm & 3) * tA; cB = B + (long)(u.pm >> 2) * lB + (long)u.pn * tB; n = 8; }
};

template <bool SCALED = true>
struct EpiPlainT {
    static constexpr bool APERM = false; static constexpr bool PERM = true;
    bf16_t* O; int ldc; float sc; int pm_mod; size_t gstride;
    __device__ __forceinline__ void operator()(const f32x4 (&acc)[2][2][4][2], const Unit& u) const {
        int t_ = threadIdx.x; asm volatile("" : "+v"(t_)); const int wid_ = __builtin_amdgcn_readfirstlane(t_ >> 6), wr = wid_ >> 2, wc = wid_ & 3, fr = t_ & 15, fq = (t_ >> 4) & 3;
        int pm = u.pm; bf16_t* base = O; if (pm_mod) { base += (size_t)(pm / pm_mod) * gstride; pm = pm % pm_mod; }
        base += (size_t)pm * BM * ldc + u.pn * BM;
        const unsigned off0 = (unsigned)((wr * 64 + fr) * ldc + wc * 32 + 8 * fq) * 2u;
#pragma unroll
        for (int ai = 0; ai < 2; ++ai)
#pragma unroll
            for (int m = 0; m < 4; ++m) { const unsigned off = off0 + (unsigned)((ai * HALF + m * 16) * ldc) * 2u;
#pragma unroll
                for (int bj = 0; bj < 2; ++bj) { f32x4 v0 = acc[ai][bj][m][0], v1 = acc[ai][bj][m][1]; if constexpr (SCALED) { v0 *= sc; v1 *= sc; }
                    u32x4 w; w.x = cvt_pk_bf16(v0[0], v0[1]); w.y = cvt_pk_bf16(v0[2], v0[3]); w.z = cvt_pk_bf16(v1[0], v1[1]); w.w = cvt_pk_bf16(v1[2], v1[3]);
                    st_off(base, off + bj * HALF * 2, w); } }
    }
};
using EpiPlain = EpiPlainT<true>; using EpiPlain1 = EpiPlainT<false>;
struct EpiZ {
    static constexpr bool APERM = false; static constexpr bool PERM = true;
    bf16_t* O; const float* naq; const float* nak; const float* gqg; const float* gkg; const f32x2* RT; const f32x2* CT; LAS float* SL; int ctx;
    __device__ __forceinline__ void operator()(const f32x4 (&acc)[2][2][4][2], const Unit& u) const {
        int t_ = threadIdx.x; asm volatile("" : "+v"(t_)); const int wid_ = __builtin_amdgcn_readfirstlane(t_ >> 6), wr = wid_ >> 2, wc = wid_ & 3, fr = t_ & 15, fq = (t_ >> 4) & 3, ln = t_ & 63;
        bf16_t* base = O + (size_t)u.pm * BM * ZLD + u.pn * BM;
        const unsigned off0 = (unsigned)((wr * 64 + fr) * ZLD + wc * 32 + 8 * fq) * 2u;
        const int pn = u.pn; const int kind = (pn >= 6 && pn < 8) ? 1 : (pn >= 8 && pn < 10) ? 2 : (pn >= 12 && pn < 16) ? 3 : (pn == 16) ? 4 : 0;
        if (kind == 0) {
#pragma unroll
            for (int ai = 0; ai < 2; ++ai)
#pragma unroll
                for (int m = 0; m < 4; ++m) { const unsigned off = off0 + (unsigned)((ai * HALF + m * 16) * ZLD) * 2u;
#pragma unroll
                    for (int bj = 0; bj < 2; ++bj) { const f32x4 v0 = acc[ai][bj][m][0], v1 = acc[ai][bj][m][1];
                        u32x4 w; w.x = cvt_pk_bf16(v0[0], v0[1]); w.y = cvt_pk_bf16(v0[2], v0[3]); w.z = cvt_pk_bf16(v1[0], v1[1]); w.w = cvt_pk_bf16(v1[2], v1[3]);
                        st_off(base, off + bj * HALF * 2, w); } }
        }
        if (kind != 0) {
#pragma unroll
            for (int ai = 0; ai < 2; ++ai)
#pragma unroll
                for (int m = 0; m < 4; ++m)
#pragma unroll
                    for (int bj = 0; bj < 2; ++bj) { const f32x4 v0 = acc[ai][bj][m][0], v1 = acc[ai][bj][m][1];
                        float ss = ((v0[0] * v0[0] + v0[1] * v0[1]) + (v0[2] * v0[2] + v0[3] * v0[3])) + ((v1[0] * v1[0] + v1[1] * v1[1]) + (v1[2] * v1[2] + v1[3] * v1[3]));
                        ss += __int_as_float(__builtin_amdgcn_ds_bpermute((ln ^ 16) << 2, __float_as_int(ss))); ss += __int_as_float(__builtin_amdgcn_ds_bpermute((ln ^ 32) << 2, __float_as_int(ss)));
                        if (fq == 0) SL[((ai * HALF + wr * 64 + m * 16 + fr) * 2 + bj) * 4 + wc] = ss; }
        }
        asm volatile("s_waitcnt lgkmcnt(0)" ::: "memory"); __builtin_amdgcn_s_barrier(); asm volatile("" ::: "memory");
        if (kind != 0) {
            const float* gn = kind == 1 ? naq : kind == 2 ? nak : kind == 3 ? gqg : gkg; const bool rope = (kind >= 3) && !ctx;
            const float qs = (kind & 1) ? QK_PRESCALE : 1.0f;
            const int d0 = (kind >= 3) ? 16 * wc + 4 * fq : 32 * wc + 8 * fq, dstep = (kind >= 3) ? 64 : 4;
            const f32x4 g0 = *(const f32x4*)(gn + d0), g1 = *(const f32x4*)(gn + d0 + dstep);
#pragma unroll
            for (int ai = 0; ai < 2; ++ai)
#pragma unroll
                for (int m = 0; m < 4; ++m) { const int rl = ai * HALF + wr * 64 + m * 16 + fr; const unsigned off = off0 + (unsigned)((ai * HALF + m * 16) * ZLD) * 2u;
                    const int tok = u.pm * BM + rl;
                    f32x2 cs[4];
                    if (rope) { const f32x2* tb = (wc < 2) ? RT + ((tok >> 6) & 255) * 32 + 16 * wc + 4 * fq : CT + (tok & 63) * 32 + 16 * (wc - 2) + 4 * fq;
#pragma unroll
                        for (int j = 0; j < 4; ++j) cs[j] = tb[j]; }
#pragma unroll
                    for (int bj = 0; bj < 2; ++bj) { const f32x4 p = *(const LAS f32x4*)(SL + (rl * 2 + bj) * 4);
                        const float rstd = qs / sqrtf(((p[0] + p[1]) + (p[2] + p[3])) * (1.0f / 128.0f) + EPS);
                        f32x4 y0 = acc[ai][bj][m][0] * rstd * g0, y1 = acc[ai][bj][m][1] * rstd * g1;
                        if (rope) {
#pragma unroll
                            for (int j = 0; j < 4; ++j) { const float a = y0[j] * cs[j].x - y1[j] * cs[j].y, b = y0[j] * cs[j].y + y1[j] * cs[j].x; y0[j] = a; y1[j] = b; } }
                        u32x4 w; w.x = cvt_pk_bf16(y0[0], y0[1]); w.y = cvt_pk_bf16(y0[2], y0[3]); w.z = cvt_pk_bf16(y1[0], y1[1]); w.w = cvt_pk_bf16(y1[2], y1[3]);
                        st_off(base, off + bj * HALF * 2, w); } }
        }
        asm volatile("s_waitcnt lgkmcnt(0)" ::: "memory");
    }
};
struct EpiF0 {
    static constexpr bool APERM = false; static constexpr bool PERM = true;
    bf16_t* XT;
    __device__ __forceinline__ void operator()(const f32x4 (&acc)[2][2][4][2], const Unit& u) const {
        int t_ = threadIdx.x; asm volatile("" : "+v"(t_)); const int wid_ = __builtin_amdgcn_readfirstlane(t_ >> 6), wr = wid_ >> 2, wc = wid_ & 3, fr = t_ & 15, fq = (t_ >> 4) & 3;
        bf16_t* xbase = XT + ((size_t)(u.pm * 128) * 128 + 2 * u.pn) * 256;
        const unsigned tA0 = (unsigned)(wc * 32 + 8 * fq);
#pragma unroll
        for (int ai = 0; ai < 2; ++ai)
#pragma unroll
            for (int m = 0; m < 4; ++m) { const unsigned cp = (unsigned)(wr * 64 + m * 16 + fr);
#pragma unroll
                for (int bj = 0; bj < 2; ++bj) { const f32x4 v0 = acc[ai][bj][m][0], v1 = acc[ai][bj][m][1];
                    u32x4 w; w.x = cvt_pk_bf16(v0[0], v0[1]); w.y = cvt_pk_bf16(v0[2], v0[3]); w.z = cvt_pk_bf16(v1[0], v1[1]); w.w = cvt_pk_bf16(v1[2], v1[3]);
                    st_off(xbase, (((cp * 128u + bj) * 2u + ai) * 128u + tA0) * 2u, w); } }
    }
};
struct EpiF0c {
    static constexpr bool APERM = false; static constexpr bool PERM = true;
    bf16_t* XTc;
    __device__ __forceinline__ void operator()(const f32x4 (&acc)[2][2][4][2], const Unit& u) const {
        int t_ = threadIdx.x; asm volatile("" : "+v"(t_)); const int wid_ = __builtin_amdgcn_readfirstlane(t_ >> 6), wr = wid_ >> 2, wc = wid_ & 3, fr = t_ & 15, fq = (t_ >> 4) & 3;
        bf16_t* xbase = XTc + (size_t)(u.pm * 128) * 512;
#pragma unroll
        for (int ai = 0; ai < 2; ++ai)
#pragma unroll
            for (int m = 0; m < 4; ++m) { const unsigned cp = (unsigned)(wr * 64 + m * 16 + fr);
#pragma unroll
                for (int bj = 0; bj < 2; ++bj) { const unsigned t0 = (unsigned)(bj * 128 + wc * 32 + 8 * fq); const f32x4 v0 = acc[ai][bj][m][0], v1 = acc[ai][bj][m][1];
                    u32x4 w; w.x = cvt_pk_bf16(v0[0], v0[1]); w.y = cvt_pk_bf16(v0[2], v0[3]); w.z = cvt_pk_bf16(v1[0], v1[1]); w.w = cvt_pk_bf16(v1[2], v1[3]);
                    st_off(xbase, ((cp * 2u + ai) * 256u + t0) * 2u, w); } }
    }
};
struct EpiF1 {
    static constexpr bool APERM = false; static constexpr bool PERM = false;
    bf16_t* YT; const f32x2* TW; float sc;
    __device__ __forceinline__ void operator()(const f32x4 (&acc)[2][2][4][2], const Unit& u) const {
        int t_ = threadIdx.x; asm volatile("" : "+v"(t_)); const int wid_ = __builtin_amdgcn_readfirstlane(t_ >> 6), wr = wid_ >> 2, wc = wid_ & 3, fr = t_ & 15, fq = (t_ >> 4) & 3;
        const unsigned k1l = (unsigned)(wc * 32 + 4 * fq);
        f32x2 twc[8], twn[8];
        { const unsigned two = (k1l * 128u + (unsigned)(wr * 64 + fr)) * 8u;
#pragma unroll
          for (int q = 0; q < 8; ++q) twc[q] = ld_off<f32x2>(TW, two + (unsigned)(16 * (q >> 2) + (q & 3)) * 1024u); }
#pragma unroll
        for (int ai = 0; ai < 2; ++ai) { const int gc = 2 * u.pm + ai, g = gc >> 7, cp = gc & 127;
            bf16_t* ybase = YT + ((size_t)(g * 128) * 128 + cp) * 256;
#pragma unroll
            for (int m = 0; m < 4; ++m) { const unsigned tB = (unsigned)(wr * 64 + m * 16 + fr);
                const unsigned yo = k1l * 65536u + tB * 2u;
                if (ai * 4 + m < 7) { const unsigned tBn = (unsigned)(wr * 64 + ((m + 1) & 3) * 16 + fr), two = (k1l * 128u + tBn) * 8u;
#pragma unroll
                    for (int q = 0; q < 8; ++q) twn[q] = ld_off<f32x2>(TW, two + (unsigned)(16 * (q >> 2) + (q & 3)) * 1024u); }
                asm volatile("" ::: "memory");
#pragma unroll
                for (int n = 0; n < 2; ++n)
#pragma unroll
                    for (int j = 0; j < 4; ++j) { const unsigned kc = (unsigned)(16 * n + j);
                        const f32x2 tw = twc[4 * n + j]; const float yr = acc[ai][0][m][n][j], yi = acc[ai][1][m][n][j];
                        const float orr = (yr * tw.x + yi * tw.y) * sc, oi = (yi * tw.x - yr * tw.y) * sc;
                        const unsigned pk = cvt_pk_bf16(orr, oi);
                        st_off(ybase, yo + kc * 65536u, (bf16_t)(pk & 0xffffu)); st_off(ybase, yo + kc * 65536u + 256u, (bf16_t)(pk >> 16)); }
#pragma unroll
                for (int q = 0; q < 8; ++q) twc[q] = twn[q]; } }
    }
};
struct EpiF2 {
    static constexpr bool APERM = false; static constexpr bool PERM = false;
    bf16_t* YS; float sc;
    __device__ __forceinline__ void operator()(const f32x4 (&acc)[2][2][4][2], const Unit& u) const {
        int t_ = threadIdx.x; asm volatile("" : "+v"(t_)); const int wid_ = __builtin_amdgcn_readfirstlane(t_ >> 6), wr = wid_ >> 2, wc = wid_ & 3, fr = t_ & 15, fq = (t_ >> 4) & 3;
        const unsigned k2l = (unsigned)(wc * 32 + 4 * fq);
#pragma unroll
        for (int ai = 0; ai < 2; ++ai) { const int gk = 2 * u.pm + ai, g = gk >> 7, k1 = gk & 127;
            bf16_t* ybase = YS + (size_t)k1 * YLD + 512 + g * 128;
#pragma unroll
            for (int m = 0; m < 4; ++m) { const unsigned cp = (unsigned)(wr * 64 + m * 16 + fr);
                const unsigned yo = (k2l * 128u * YLD + cp) * 2u;
#pragma unroll
                for (int n = 0; n < 2; ++n)
#pragma unroll
                    for (int j = 0; j < 4; ++j) { const unsigned kc = (unsigned)(16 * n + j);
                        const unsigned pk = cvt_pk_bf16(acc[ai][0][m][n][j] * sc, 0.f);
                        st_off(ybase, yo + kc * (128u * YLD * 2u), (bf16_t)(pk & 0xffffu)); }
                asm volatile("" ::: "memory"); } }
    }
};
struct EpiF1s {
    static constexpr bool APERM = false; static constexpr bool PERM = true;
    bf16_t* YT; const f32x2* TW; float sc;
    __device__ __forceinline__ void operator()(const f32x4 (&acc)[2][2][4][2], const Unit& u) const {
        int t_ = threadIdx.x; asm volatile("" : "+v"(t_)); const int wid_ = __builtin_amdgcn_readfirstlane(t_ >> 6), wr = wid_ >> 2, wc = wid_ & 3, fr = t_ & 15, fq = (t_ >> 4) & 3;
        const unsigned tB0 = (unsigned)(wc * 32 + 8 * fq);
#pragma unroll
        for (int m = 0; m < 4; ++m) { const unsigned k1 = (unsigned)(wr * 64 + m * 16 + fr);
            f32x4 tw[4];
#pragma unroll
            for (int q = 0; q < 4; ++q) tw[q] = ld_off<f32x4>(TW, (k1 * 128u + tB0) * 8u + q * 16u);
#pragma unroll
            for (int bj = 0; bj < 2; ++bj) { const int gc = 2 * u.pn + bj, g = gc >> 7, cp = gc & 127;
                bf16_t* ybase = YT + ((size_t)(g * 128) * 128 + cp) * 256;
                float orr[8], oi[8];
#pragma unroll
                for (int n = 0; n < 2; ++n)
#pragma unroll
                    for (int j = 0; j < 4; ++j) { const int e = 4 * n + j; const float c = tw[e >> 1][2 * (e & 1)], s = tw[e >> 1][2 * (e & 1) + 1];
                        const float yr = acc[0][bj][m][n][j], yi = acc[1][bj][m][n][j];
                        orr[e] = (yr * c + yi * s) * sc; oi[e] = (yi * c - yr * s) * sc; }
                u32x4 wr_, wi_; wr_.x = cvt_pk_bf16(orr[0], orr[1]); wr_.y = cvt_pk_bf16(orr[2], orr[3]); wr_.z = cvt_pk_bf16(orr[4], orr[5]); wr_.w = cvt_pk_bf16(orr[6], orr[7]);
                wi_.x = cvt_pk_bf16(oi[0], oi[1]); wi_.y = cvt_pk_bf16(oi[2], oi[3]); wi_.z = cvt_pk_bf16(oi[4], oi[5]); wi_.w = cvt_pk_bf16(oi[6], oi[7]);
                const unsigned yo = k1 * 65536u + tB0 * 2u;
                st_off(ybase, yo, wr_); st_off(ybase, yo + 256u, wi_); }
            asm volatile("" ::: "memory"); }
    }
};
struct EpiF2s {
    static constexpr bool APERM = false; static constexpr bool PERM = true;
    bf16_t* YS; float sc;
    __device__ __forceinline__ void operator()(const f32x4 (&acc)[2][2][4][2], const Unit& u) const {
        int t_ = threadIdx.x; asm volatile("" : "+v"(t_)); const int wid_ = __builtin_amdgcn_readfirstlane(t_ >> 6), wr = wid_ >> 2, wc = wid_ & 3, fr = t_ & 15, fq = (t_ >> 4) & 3;
        const unsigned cp0 = (unsigned)(wc * 32 + 8 * fq);
#pragma unroll
        for (int bj = 0; bj < 2; ++bj) { const int gk = 2 * u.pn + bj, g = gk >> 7, k1 = gk & 127;
            bf16_t* ybase = YS + (size_t)k1 * YLD + 512 + g * 128;
#pragma unroll
            for (int m = 0; m < 4; ++m) { const unsigned k2 = (unsigned)(wr * 64 + m * 16 + fr);
                const f32x4 v0 = acc[0][bj][m][0] * sc, v1 = acc[0][bj][m][1] * sc;
                u32x4 w; w.x = cvt_pk_bf16(v0[0], v0[1]); w.y = cvt_pk_bf16(v0[2], v0[3]); w.z = cvt_pk_bf16(v1[0], v1[1]); w.w = cvt_pk_bf16(v1[2], v1[3]);
                st_off(ybase, (k2 * 128u * YLD + cp0) * 2u, w); }
            asm volatile("" ::: "memory"); }
    }
};
struct EpiF1c {
    static constexpr bool APERM = false; static constexpr bool PERM = false;
    bf16_t* YS; float sc;
    __device__ __forceinline__ void operator()(const f32x4 (&acc)[2][2][4][2], const Unit& u) const {
        int t_ = threadIdx.x; asm volatile("" : "+v"(t_)); const int wid_ = __builtin_amdgcn_readfirstlane(t_ >> 6), wr = wid_ >> 2, wc = wid_ & 3, fr = t_ & 15, fq = (t_ >> 4) & 3;
        bf16_t* ybase = YS + (size_t)SEQ * YLD + 512 + u.pm * 256;
        const unsigned kl = (unsigned)(wc * 32 + 4 * fq);
#pragma unroll
        for (int ai = 0; ai < 2; ++ai)
#pragma unroll
            for (int m = 0; m < 4; ++m) { const unsigned row = (unsigned)(ai * 128 + wr * 64 + m * 16 + fr);
                const unsigned yo = (kl * YLD + row) * 2u;
#pragma unroll
                for (int bj = 0; bj < 2; ++bj)
#pragma unroll
                    for (int n = 0; n < 2; ++n)
#pragma unroll
                        for (int j = 0; j < 4; ++j) { const unsigned kc = (unsigned)(bj * 128 + 16 * n + j);
                            const unsigned pk = cvt_pk_bf16(acc[ai][bj][m][n][j] * sc, 0.f);
                            st_off(ybase, yo + kc * (YLD * 2u), (bf16_t)(pk & 0xffffu)); }
                asm volatile("" ::: "memory"); }
    }
};
struct EpiGate {
    static constexpr bool APERM = false; static constexpr bool PERM = true;
    const bf16_t* P; const float* bias; bf16_t* MG;
    __device__ __forceinline__ void operator()(const f32x4 (&acc)[2][2][4][2], const Unit& u) const {
        int t_ = threadIdx.x; asm volatile("" : "+v"(t_)); const int wid_ = __builtin_amdgcn_readfirstlane(t_ >> 6), wr = wid_ >> 2, wc = wid_ & 3, fr = t_ & 15, fq = (t_ >> 4) & 3;
        const int d8 = u.pn * 64 + wc * 16 + 8 * (fq >> 1), bsel = fq & 1;
        f32x4 bv[2][2];
#pragma unroll
        for (int bj = 0; bj < 2; ++bj)
#pragma unroll
            for (int n = 0; n < 2; ++n) bv[bj][n] = *(const f32x4*)(bias + (2 * bsel + bj) * 2048 + d8 + 4 * n) * GATE_PRESCALE;
        const bf16_t* pbase = P + (size_t)u.pm * BM * PLD; bf16_t* mbase = MG + (size_t)u.pm * BM * D;
        const unsigned pcol = (unsigned)((2 * bsel) * 2048 + d8);
        u32x4 pwc[2], pwn[2];
        { const unsigned po = ((unsigned)(wr * 64 + fr) * PLD + pcol) * 2u;
#pragma unroll
          for (int bj = 0; bj < 2; ++bj) pwc[bj] = ld_off<u32x4>(pbase, po + bj * 4096u); }
#pragma unroll
        for (int ai = 0; ai < 2; ++ai)
#pragma unroll
            for (int m = 0; m < 4; ++m) { const unsigned row = (unsigned)(ai * HALF + wr * 64 + m * 16 + fr);
                if (ai * 4 + m < 7) { const int g1 = ai * 4 + m + 1; const unsigned po = ((unsigned)((g1 >> 2) * HALF + wr * 64 + (g1 & 3) * 16 + fr) * PLD + pcol) * 2u;
#pragma unroll
                    for (int bj = 0; bj < 2; ++bj) pwn[bj] = ld_off<u32x4>(pbase, po + bj * 4096u); }
                asm volatile("" ::: "memory");
                float s[8];
#pragma unroll
                for (int e = 0; e < 8; ++e) s[e] = 0.f;
#pragma unroll
                for (int bj = 0; bj < 2; ++bj) { const u32x4 pw = pwc[bj];
#pragma unroll
                    for (int n = 0; n < 2; ++n) { const f32x4 x = acc[ai][bj][m][n] + bv[bj][n]; f32x4 gt;
#pragma unroll
                        for (int j = 0; j < 4; ++j) gt[j] = __builtin_amdgcn_rcpf(1.0f + __builtin_amdgcn_exp2f(x[j]));
                        const unsigned w0 = pw[2 * n], w1 = pw[2 * n + 1];
                        s[4 * n + 0] += gt[0] * bf_lo(w0); s[4 * n + 1] += gt[1] * bf_hi(w0); s[4 * n + 2] += gt[2] * bf_lo(w1); s[4 * n + 3] += gt[3] * bf_hi(w1); } }
#pragma unroll
                for (int e = 0; e < 8; ++e) s[e] += __int_as_float(__builtin_amdgcn_ds_swizzle(__float_as_int(s[e]), 0x401F));
                if (bsel == 0) { u32x4 o; o.x = cvt_pk_bf16(s[0], s[1]); o.y = cvt_pk_bf16(s[2], s[3]); o.z = cvt_pk_bf16(s[4], s[5]); o.w = cvt_pk_bf16(s[6], s[7]);
                    st_off(mbase, (row * D + d8) * 2u, o); }
#pragma unroll
                for (int bj = 0; bj < 2; ++bj) pwc[bj] = pwn[bj]; }
    }
};
struct EpiF32 {
    static constexpr bool APERM = false; static constexpr bool PERM = false;
    float* O; int ldc; size_t sstride;
    __device__ __forceinline__ void operator()(const f32x4 (&acc)[2][2][4][2], const Unit& u) const {
        int t_ = threadIdx.x; asm volatile("" : "+v"(t_)); const int wid_ = __builtin_amdgcn_readfirstlane(t_ >> 6), wr = wid_ >> 2, wc = wid_ & 3, fr = t_ & 15, fq = (t_ >> 4) & 3;
        float* base = O + (size_t)u.pm * sstride + u.pn * BM;
        const unsigned off0 = (unsigned)((wr * 64 + fr) * ldc + wc * 32 + 4 * fq) * 4u;
#pragma unroll
        for (int ai = 0; ai < 2; ++ai)
#pragma unroll
            for (int m = 0; m < 4; ++m) { const unsigned off = off0 + (unsigned)((ai * HALF + m * 16) * ldc) * 4u;
#pragma unroll
                for (int bj = 0; bj < 2; ++bj)
#pragma unroll
                    for (int n = 0; n < 2; ++n) st_off(base, off + (bj * HALF + n * 16) * 4, acc[ai][bj][m][n]); }
    }
};
__device__ __forceinline__ float dpp_prev(float x) { return __int_as_float(__builtin_amdgcn_mov_dpp(__float_as_int(x), 0x121, 0xF, 0xF, false)); }
__device__ __forceinline__ float dpp_next(float x) { return __int_as_float(__builtin_amdgcn_mov_dpp(__float_as_int(x), 0x12F, 0xF, 0xF, false)); }
__device__ __forceinline__ float dpp_prev_e(float edge, float x) { return __int_as_float(__builtin_amdgcn_update_dpp(__float_as_int(edge), __float_as_int(x), 0x111, 0xF, 0xF, false)); }
__device__ __forceinline__ float dpp_next_e(float edge, float x) { return __int_as_float(__builtin_amdgcn_update_dpp(__float_as_int(edge), __float_as_int(x), 0x101, 0xF, 0xF, false)); }
struct EpiUpConv {
    static constexpr bool APERM = true; static constexpr bool PERM = true;
    bf16_t* ACTp; float* SB; const float* fw; LAS float* HL;
    __device__ __forceinline__ void operator()(const f32x4 (&acc)[2][2][4][2], const Unit& u) const {
        int t_ = threadIdx.x; asm volatile("" : "+v"(t_)); const int wid_ = __builtin_amdgcn_readfirstlane(t_ >> 6), wr = wid_ >> 2, wc = wid_ & 3, fr = t_ & 15, fq = (t_ >> 4) & 3;
        const int cl = wc * 32 + 8 * fq, ch0 = u.pn * 128 + cl;
#pragma unroll
        for (int ai = 0; ai < 2; ++ai) {
            if (fr == 0) { LAS float* h = HL + ((ai * 2 + wr) * 2 + 0) * 256 + cl;
                *(LAS f32x4*)h = acc[ai][0][0][0]; *(LAS f32x4*)(h + 4) = acc[ai][0][0][1]; *(LAS f32x4*)(h + 128) = acc[ai][1][0][0]; *(LAS f32x4*)(h + 132) = acc[ai][1][0][1]; }
            if (fr == 15) { LAS float* h = HL + ((ai * 2 + wr) * 2 + 1) * 256 + cl;
                *(LAS f32x4*)h = acc[ai][0][3][0]; *(LAS f32x4*)(h + 4) = acc[ai][0][3][1]; *(LAS f32x4*)(h + 128) = acc[ai][1][3][0]; *(LAS f32x4*)(h + 132) = acc[ai][1][3][1]; }
        }
        asm volatile("s_waitcnt lgkmcnt(0)" ::: "memory"); __builtin_amdgcn_s_barrier(); asm volatile("" ::: "memory");
        bf16_t* abase = ACTp + (size_t)u.pm * BM * FF + u.pn * 128; float* sbase = SB + (size_t)u.pm * 4 * ULD + u.pn * 256;
        u32x2 wkeep[2][4];
#pragma unroll
        for (int n = 0; n < 2; ++n) {
            f32x4 wa[3], wg[3];
#pragma unroll
            for (int dd = 0; dd < 3; ++dd) { wa[dd] = *(const f32x4*)(fw + dd * ULD + ch0 + 4 * n); wg[dd] = *(const f32x4*)(fw + dd * ULD + FF + ch0 + 4 * n); }
#pragma unroll
            for (int ai = 0; ai < 2; ++ai) {
                const int rid_t = (wr == 1) ? ((ai * 2 + 0) * 2 + 1) : (ai == 1 ? 3 : -1), rid_b = (wr == 0) ? ((ai * 2 + 1) * 2 + 0) : (ai == 0 ? 4 : -1);
#pragma unroll
                for (int m = 0; m < 4; ++m) {
                    const unsigned row = (unsigned)(ai * HALF + wr * 64 + 4 * fr + m);
                    f32x4 o;
#pragma unroll
                    for (int j = 0; j < 4; ++j) {
                        float ua, ug;
                        { const float cur = acc[ai][0][m][n][j]; float pv, nx;
                          if (m > 0) pv = acc[ai][0][m - 1][n][j]; else pv = dpp_prev_e((rid_t >= 0) ? HL[rid_t * 256 + cl + 4 * n + j] : 0.f, acc[ai][0][3][n][j]);
                          if (m < 3) nx = acc[ai][0][m + 1][n][j]; else nx = dpp_next_e((rid_b >= 0) ? HL[rid_b * 256 + cl + 4 * n + j] : 0.f, acc[ai][0][0][n][j]);
                          ua = pv * wa[0][j] + cur * wa[1][j] + nx * wa[2][j]; }
                        { const float cur = acc[ai][1][m][n][j]; float pv, nx;
                          if (m > 0) pv = acc[ai][1][m - 1][n][j]; else pv = dpp_prev_e((rid_t >= 0) ? HL[rid_t * 256 + 128 + cl + 4 * n + j] : 0.f, acc[ai][1][3][n][j]);
                          if (m < 3) nx = acc[ai][1][m + 1][n][j]; else nx = dpp_next_e((rid_b >= 0) ? HL[rid_b * 256 + 128 + cl + 4 * n + j] : 0.f, acc[ai][1][0][n][j]);
                          ug = pv * wg[0][j] + cur * wg[1][j] + nx * wg[2][j]; }
                        o[j] = ua * __builtin_amdgcn_rcpf(1.0f + __builtin_amdgcn_exp2f(-1.4426950408889634f * ua)) * ug;
                    }
                    u32x2 w; w.x = cvt_pk_bf16(o[0], o[1]); w.y = cvt_pk_bf16(o[2], o[3]);
                    const bool edge = (row == 0u) || (row == 255u);
                    if (n == 0) wkeep[ai][m] = w;
                    else if (!edge) { u32x4 w4; w4.x = wkeep[ai][m].x; w4.y = wkeep[ai][m].y; w4.z = w.x; w4.w = w.y; st_off(abase, (row * FF + cl) * 2u, w4); }
                    if ((ai == 0 && wr == 0 && fr == 0 && m < 2) || (ai == 1 && wr == 1 && fr == 15 && m >= 2)) { const unsigned k = (unsigned)m;
                        const unsigned so = (k * ULD + cl + 4 * n) * 4u;
                        st_off(sbase, so, acc[ai][0][m][n]); st_off(sbase, so + 512u, acc[ai][1][m][n]); }
                    asm volatile("" ::: "memory");
                }
            }
        }
        asm volatile("s_waitcnt lgkmcnt(0)" ::: "memory");
    }
};
struct EpiResid {
    static constexpr bool APERM = false; static constexpr bool PERM = true;
    const void* base; void* out; const float* gv; int bin, bout;
    __device__ __forceinline__ void operator()(const f32x4 (&acc)[2][2][4][2], const Unit& u) const {
        int t_ = threadIdx.x; asm volatile("" : "+v"(t_)); const int wid_ = __builtin_amdgcn_readfirstlane(t_ >> 6), wr = wid_ >> 2, wc = wid_ & 3, fr = t_ & 15, fq = (t_ >> 4) & 3;
        const size_t pofs = (size_t)u.pm * BM * D; const char* bs_ = (const char*)base + pofs * (bin ? 2 : 4); char* out_ = (char*)out + pofs * (bout ? 2 : 4);
        const int row0 = wr * 64 + fr, col0 = u.pn * BM + wc * 32 + 8 * fq;
        f32x4 g[2][2];
#pragma unroll
        for (int bj = 0; bj < 2; ++bj)
#pragma unroll
            for (int n = 0; n < 2; ++n) g[bj][n] = *(const f32x4*)(gv + col0 + bj * HALF + n * 4);
#define LDB8(dst, eoff) do { if (bin) { const u32x4 w_ = ld_off<u32x4>(bs_, (eoff) * 2u); dst[0] = (f32x4){bf_lo(w_.x), bf_hi(w_.x), bf_lo(w_.y), bf_hi(w_.y)}; dst[1] = (f32x4){bf_lo(w_.z), bf_hi(w_.z), bf_lo(w_.w), bf_hi(w_.w)}; } \
                                  else { dst[0] = ld_off<f32x4>(bs_, (eoff) * 4u); dst[1] = ld_off<f32x4>(bs_, (eoff) * 4u + 16u); } } while (0)
        f32x4 bc[2][2], bn[2][2];
        { const unsigned eo = (unsigned)(row0 * D + col0);
#pragma unroll
          for (int bj = 0; bj < 2; ++bj) LDB8(bc[bj], eo + bj * HALF); }
#pragma unroll
        for (int ai = 0; ai < 2; ++ai)
#pragma unroll
            for (int m = 0; m < 4; ++m) { const unsigned eo = (unsigned)((row0 + ai * HALF + m * 16) * D + col0);
                if (ai * 4 + m < 7) { const int g1 = ai * 4 + m + 1; const unsigned e1 = (unsigned)((row0 + (g1 >> 2) * HALF + (g1 & 3) * 16) * D + col0);
#pragma unroll
                    for (int bj = 0; bj < 2; ++bj) LDB8(bn[bj], e1 + bj * HALF); }
                asm volatile("" ::: "memory");
#pragma unroll
                for (int bj = 0; bj < 2; ++bj) { const f32x4 x0 = bc[bj][0] + g[bj][0] * acc[ai][bj][m][0], x1 = bc[bj][1] + g[bj][1] * acc[ai][bj][m][1]; const unsigned ee = eo + bj * HALF;
                    if (bout) { u32x4 w; w.x = cvt_pk_bf16(x0[0], x0[1]); w.y = cvt_pk_bf16(x0[2], x0[3]); w.z = cvt_pk_bf16(x1[0], x1[1]); w.w = cvt_pk_bf16(x1[2], x1[3]); st_off(out_, ee * 2u, w); }
                    else { st_off(out_, ee * 4u, x0); st_off(out_, ee * 4u + 16u, x1); }
                    bc[bj][0] = bn[bj][0]; bc[bj][1] = bn[bj][1]; } }
#undef LDB8
    }
};

template <class Epi, class Prob, class Sched>
__device__ __forceinline__ void gemm_phase(LAS unsigned char* lds, const Prob& P, const Sched& S, const Epi& E) {
    int tid = threadIdx.x; asm volatile("" : "+v"(tid));
    const int wid = __builtin_amdgcn_readfirstlane(tid >> 6), lane = tid & 63, wr = wid >> 2, wc = wid & 3, fr = lane & 15, fq = lane >> 4;
    unsigned voffA[2], voffB[2];
#pragma unroll
    for (int i = 0; i < 2; ++i) { int R, C; stage_rc(tid * 16 + i * 8192, R, C); const int Rb = Epi::PERM ? ((R & ~31) + perm32(R & 31)) : R;
        const int Ra = Epi::APERM ? ((R & ~63) + 4 * (R & 15) + ((R >> 4) & 3)) : R;
        voffA[i] = (unsigned)(Ra * P.lda + C) * 2u; voffB[i] = (unsigned)(Rb * P.ldb + C) * 2u; }
    const long kstep = (long)(BK * 2);
    const long hA = P.hA, hB = P.hB;
    const unsigned ldsw = (unsigned)wid * 1024u;
    const int aoff = lds_byte(wr * 64 + fr, fq * 8), boff = lds_byte(wc * 32 + fr, fq * 8);
#define PG8_SA(b, h) (((b) * 2 + (h)) * HTB)
#define PG8_SB(b, h) ((4 + (b) * 2 + (h)) * HTB)
    const unsigned ldsm0 = (unsigned)__builtin_amdgcn_readfirstlane((int)(unsigned)(uintptr_t)lds) + ldsw;
#define PG8_STAGE(bufoff, gbase, voff) do { _Pragma("unroll") for (int _i = 0; _i < 2; ++_i) \
        asm volatile("s_mov_b32 m0, %2\n\ts_nop 0\n\tglobal_load_lds_dwordx4 %0, %1" :: "v"((voff)[_i]), "s"((const char*)(gbase)), "s"(ldsm0 + (unsigned)((bufoff) + _i * 8192)) : "memory", "m0"); } while (0)
#define PG8_LDA(dst, b, h) do { _Pragma("unroll") for (int m = 0; m < 4; ++m) _Pragma("unroll") for (int k = 0; k < 2; ++k) dst[m][k] = *(const LAS bf16x8*)(lds + PG8_SA(b, h) + aoff + m * 2048 + k * 1024); } while (0)
#define PG8_LDB(dst, b, h) do { _Pragma("unroll") for (int n = 0; n < 2; ++n) _Pragma("unroll") for (int k = 0; k < 2; ++k) dst[n][k] = *(const LAS bf16x8*)(lds + PG8_SB(b, h) + boff + n * 2048 + k * 1024); } while (0)
#define PG8_MMA(ai, bj, At, Bt) do { __builtin_amdgcn_s_setprio(1); _Pragma("unroll") for (int m = 0; m < 4; ++m) _Pragma("unroll") for (int n = 0; n < 2; ++n) _Pragma("unroll") for (int k = 0; k < 2; ++k) \
        acc[ai][bj][m][n] = __builtin_amdgcn_mfma_f32_16x16x32_bf16(Bt[n][k], At[m][k], acc[ai][bj][m][n], 0, 0, 0); __builtin_amdgcn_s_setprio(0); } while (0)
#define PG8_MMAZ(ai, bj, At, Bt) do { __builtin_amdgcn_s_setprio(1); _Pragma("unroll") for (int m = 0; m < 4; ++m) _Pragma("unroll") for (int n = 0; n < 2; ++n) { \
        acc[ai][bj][m][n] = __builtin_amdgcn_mfma_f32_16x16x32_bf16(Bt[n][0], At[m][0], (f32x4){0.f, 0.f, 0.f, 0.f}, 0, 0, 0); \
        acc[ai][bj][m][n] = __builtin_amdgcn_mfma_f32_16x16x32_bf16(Bt[n][1], At[m][1], acc[ai][bj][m][n], 0, 0, 0); } __builtin_amdgcn_s_setprio(0); } while (0)
#define PG8_WAIT_V(n) asm volatile("s_waitcnt vmcnt(" #n ")" ::: "memory")
#define PG8_WAIT_L(n) asm volatile("s_waitcnt lgkmcnt(" #n ")" ::: "memory")
#define PG8_BAR __builtin_amdgcn_s_barrier()
#define PG8_SCHED __builtin_amdgcn_sched_barrier(0)
    Unit cur, nxt; int ui = 0;
    if (!S.next(0, cur)) return;
    f32x4 acc[2][2][4][2];
    bf16x8 At[4][2], B0[2][2], B1[2][2];
    const char* cA; const char* cB; int nt;
    P.locate(cur, cA, cB, nt);
    PG8_STAGE(PG8_SB(0, 0), cB, voffB); PG8_STAGE(PG8_SB(0, 1), cB + hB, voffB); PG8_STAGE(PG8_SA(0, 0), cA, voffA); PG8_STAGE(PG8_SA(0, 1), cA + hA, voffA);
    if (wr == 1) PG8_BAR;
    PG8_WAIT_V(2); PG8_BAR;
    PG8_STAGE(PG8_SB(1, 0), cB + kstep, voffB); PG8_STAGE(PG8_SA(1, 0), cA + kstep, voffA); PG8_STAGE(PG8_SB(1, 1), cB + hB + kstep, voffB);
    PG8_WAIT_V(6); PG8_BAR;
    for (;;) {
        const bool has_next = S.next(ui + 1, nxt);
        const char* nA = cA; const char* nB = cB; int nnt = nt;
        if (has_next) P.locate(nxt, nA, nB, nnt);
#define PG8_KSTEP(MM) do { \
            const bool last = (t == nt - 2); \
            const char* a1 = cA + (long)(t + 1) * kstep; \
            const char* a2 = last ? nA : cA + (long)(t + 2) * kstep; const char* b2 = last ? nB : cB + (long)(t + 2) * kstep; \
            const char* a3 = a2 + kstep; const char* b3 = b2 + kstep; \
            PG8_LDB(B0, 0, 0); PG8_LDB(B1, 0, 1); PG8_SCHED; PG8_LDA(At, 0, 0); PG8_STAGE(PG8_SA(1, 1), a1 + hA, voffA); \
            PG8_WAIT_V(8); PG8_WAIT_L(0); PG8_BAR; MM(0, 0, At, B0); MM(0, 1, At, B1); PG8_BAR; PG8_SCHED; \
            PG8_LDA(At, 0, 1); PG8_STAGE(PG8_SB(0, 0), b2, voffB); PG8_STAGE(PG8_SB(0, 1), b2 + hB, voffB); PG8_STAGE(PG8_SA(0, 0), a2, voffA); \
            PG8_WAIT_V(8); PG8_WAIT_L(0); PG8_BAR; MM(1, 0, At, B0); MM(1, 1, At, B1); PG8_BAR; PG8_SCHED; \
            PG8_LDB(B0, 1, 0); PG8_LDB(B1, 1, 1); PG8_SCHED; PG8_LDA(At, 1, 0); PG8_STAGE(PG8_SA(0, 1), a2 + hA, voffA); \
            PG8_WAIT_V(8); PG8_WAIT_L(0); PG8_BAR; PG8_MMA(0, 0, At, B0); PG8_MMA(0, 1, At, B1); PG8_BAR; PG8_SCHED; \
            PG8_LDA(At, 1, 1); PG8_STAGE(PG8_SB(1, 0), b3, voffB); PG8_STAGE(PG8_SB(1, 1), b3 + hB, voffB); PG8_STAGE(PG8_SA(1, 0), a3, voffA); \
            PG8_WAIT_V(8); PG8_WAIT_L(0); PG8_BAR; PG8_MMA(1, 0, At, B0); PG8_MMA(1, 1, At, B1); PG8_BAR; PG8_SCHED; } while (0)
        { int t = 0; PG8_KSTEP(PG8_MMAZ);
          for (t = 2; t < nt; t += 2) PG8_KSTEP(PG8_MMA); }
#undef PG8_KSTEP
        if (wr == 0) PG8_BAR;
        E(acc, cur);
        if (!has_next) break;
        cur = nxt; cA = nA; cB = nB; nt = nnt; ++ui;
        if (wr == 1) PG8_BAR;
    }
    PG8_WAIT_V(0);
    PG8_BAR;
#undef PG8_SA
#undef PG8_SB
#undef PG8_STAGE
#undef PG8_LDA
#undef PG8_LDB
#undef PG8_MMA
#undef PG8_MMAZ
#undef PG8_WAIT_V
#undef PG8_WAIT_L
#undef PG8_BAR
#undef PG8_SCHED
}
}

namespace att {
constexpr int NW = 8, QBLK = 32, KVBLK = 64;
constexpr float SCALE = 0.088388347648318440f;
constexpr float THR = 8.f;
constexpr float NEGV = -1.0e30f;
constexpr size_t SHM_V = KVBLK * 128 * 2, SHM_K = KVBLK * 128 * 2, SHM_ATTN = 2 * SHM_V + 2 * SHM_K + NW * 64 * 4, SHM_BIAS = SHM_ATTN;
#define KSWZ(row, colB) ((row) * 256 + ((colB) ^ (((row) & 7) << 4)))
#define SBAR() __builtin_amdgcn_sched_barrier(0)
__device__ __forceinline__ int crow(int r, int hi) { return (r & 3) + 8 * (r >> 2) + 4 * hi; }
__device__ __forceinline__ void partialSM(f32x16& p0) {
  for (int r = 0; r < 16; ++r) p0[r] = __builtin_amdgcn_exp2f(p0[r]);
}
__device__ __forceinline__ void finishSM(f32x16& p0, f32x16& p1, float& l_reg, bf16x8& pa0, bf16x8& pa1, bf16x8& pa2, bf16x8& pa3) {
  for (int r = 0; r < 16; ++r) p1[r] = __builtin_amdgcn_exp2f(p1[r]);
  float ps = 0; for (int r = 0; r < 16; ++r) ps += p0[r]; for (int r = 0; r < 16; ++r) ps += p1[r];
  l_reg += ps;
#define PK4(P, BASE, OUT) do { unsigned a0 = cvt_pk_bf16(P[BASE + 0], P[BASE + 1]), a1 = cvt_pk_bf16(P[BASE + 2], P[BASE + 3]);   \
    unsigned b0 = cvt_pk_bf16(P[BASE + 4], P[BASE + 5]), b1 = cvt_pk_bf16(P[BASE + 6], P[BASE + 7]);                              \
    auto r0 = __builtin_amdgcn_permlane32_swap(a0, b0, false, false); auto r1 = __builtin_amdgcn_permlane32_swap(a1, b1, false, false); \
    u32x4 w = {r0[0], r1[0], r0[1], r1[1]}; OUT = *reinterpret_cast<bf16x8*>(&w); } while (0)
  PK4(p0, 0, pa0); PK4(p0, 8, pa1); PK4(p1, 0, pa2); PK4(p1, 8, pa3);
#undef PK4
}
__device__ __forceinline__ void qkt(f32x16& p0, f32x16& p1, const bf16_t* Ks, const bf16x8* qr, int r32, int hi, const f32x16& seed) {
  for (int d0 = 0; d0 < 8; ++d0) { int cb = (d0 * 16 + hi * 8) * 2;
    bf16x8 b0 = *reinterpret_cast<const bf16x8*>((const char*)Ks + KSWZ(r32, cb));
    bf16x8 b1 = *reinterpret_cast<const bf16x8*>((const char*)Ks + KSWZ(32 + r32, cb));
    p0 = __builtin_amdgcn_mfma_f32_32x32x16_bf16(b0, qr[d0], d0 == 0 ? seed : p0, 0, 0, 0);
    p1 = __builtin_amdgcn_mfma_f32_32x32x16_bf16(b1, qr[d0], d0 == 0 ? seed : p1, 0, 0, 0); }
}
__device__ __forceinline__ int v_st(int k, int c) { const int kk = (k & ~0xC) | ((k & 4) << 1) | ((k & 8) >> 1); return ((kk >> 3) * 4 + (c >> 5)) * 512 + ((kk & 7) * 32 + (c & 31)) * 2; }
__device__ __forceinline__ int v_rd_base(int lane) { return ((lane & 3) << 3) | (((lane >> 2) & 3) << 6) | (((lane >> 4) & 1) << 5) | (((lane >> 5) & 1) << 8); }
constexpr int v_rd_off(int d0, int ks, int half) { return d0 * 512 + ks * 4096 + half * 2048; }
template <int OFF> __device__ __forceinline__ s16x4 tr_read(int vb) {
  s16x4 r; asm volatile("ds_read_b64_tr_b16 %0, %1 offset:%2" : "=&v"(r) : "v"(vb), "i"(OFF) : "memory"); return r;
}
template <int D0> __device__ __forceinline__ void pv_one(f32x16& od, int vb, bf16x8 pa0, bf16x8 pa1, bf16x8 pa2, bf16x8 pa3) {
  const s16x4 l0 = tr_read<v_rd_off(D0, 0, 0)>(vb), h0 = tr_read<v_rd_off(D0, 0, 1)>(vb), l1 = tr_read<v_rd_off(D0, 1, 0)>(vb), h1 = tr_read<v_rd_off(D0, 1, 1)>(vb);
  const s16x4 l2 = tr_read<v_rd_off(D0, 2, 0)>(vb), h2 = tr_read<v_rd_off(D0, 2, 1)>(vb), l3 = tr_read<v_rd_off(D0, 3, 0)>(vb), h3 = tr_read<v_rd_off(D0, 3, 1)>(vb);
  asm volatile("s_waitcnt lgkmcnt(0)" ::: "memory"); SBAR();
#define PK(L, H) (bf16x8){L[0], L[1], L[2], L[3], H[0], H[1], H[2], H[3]}
  od = __builtin_amdgcn_mfma_f32_32x32x16_bf16(PK(l0, h0), pa0, od, 0, 0, 0);
  od = __builtin_amdgcn_mfma_f32_32x32x16_bf16(PK(l1, h1), pa1, od, 0, 0, 0);
  od = __builtin_amdgcn_mfma_f32_32x32x16_bf16(PK(l2, h2), pa2, od, 0, 0, 0);
  od = __builtin_amdgcn_mfma_f32_32x32x16_bf16(PK(l3, h3), pa3, od, 0, 0, 0);
#undef PK
}
__device__ __forceinline__ void pv_d0(f32x16* o, int vb, bf16x8 pa0, bf16x8 pa1, bf16x8 pa2, bf16x8 pa3) {
  pv_one<0>(o[0], vb, pa0, pa1, pa2, pa3); pv_one<1>(o[1], vb, pa0, pa1, pa2, pa3); pv_one<2>(o[2], vb, pa0, pa1, pa2, pa3); pv_one<3>(o[3], vb, pa0, pa1, pa2, pa3);
}
__device__ __forceinline__ void na_mask(f32x16& p0, f32x16& p1, int kr, int rq, int r0q, int cq, int c0q, const float* bias, int hi) {
  const bool rowok = (kr >= r0q) && (kr <= r0q + 7);
  if (!rowok) {
    for (int r = 0; r < 16; ++r) { p0[r] = NEGV; p1[r] = NEGV; }
  } else {
    const float* bp = bias + (kr - rq + 7) * 31 + (15 - cq);
#pragma unroll
    for (int r = 0; r < 16; ++r) { const int kc0 = crow(r, hi), kc1 = kc0 + 32;
      const bool v0 = (kc0 >= c0q) && (kc0 <= c0q + 15), v1 = (kc1 >= c0q) && (kc1 <= c0q + 15);
      const float b0 = bp[v0 ? kc0 : cq], b1 = bp[v1 ? kc1 : cq];
      p0[r] = v0 ? p0[r] + b0 : NEGV; p1[r] = v1 ? p1[r] + b1 : NEGV;
      if ((r & 3) == 3) SBAR(); }
  }
}
__device__ __forceinline__ void attn_body(const bf16_t* __restrict__ Qb, const bf16_t* __restrict__ Kh, const bf16_t* __restrict__ Vh, bf16_t* __restrict__ Ob,
                                          int NT, int ldq, int ldk, int ldo, char* lds, float negM) {
  int tid = threadIdx.x; asm volatile("" : "+v"(tid));
  const int wid = tid >> 6, lane = tid & 63, r32 = lane & 31, hi = lane >> 5;
  bf16_t* V_lds = (bf16_t*)lds; bf16_t* K_lds = (bf16_t*)(lds + 2 * SHM_V);
  float* ws = (float*)(lds + 2 * SHM_V + 2 * SHM_K) + wid * 64; float* li_l = ws;
  float l_reg = 0; f32x16 o[4] = {}; bf16x8 qr[8];
  const bf16_t* Qw = Qb + (long)(wid * QBLK + r32) * ldq + hi * 8;
#pragma unroll
  for (int d0 = 0; d0 < 8; ++d0) qr[d0] = *reinterpret_cast<const bf16x8*>(Qw + d0 * 16);
  const int sr = tid >> 4, sc = (tid & 15) * 8, vst0 = v_st(sr, sc), vst1 = v_st(32 + sr, sc);
  const int vb0 = (int)(uintptr_t)V_lds + v_rd_base(lane);
  const unsigned lofs = (unsigned)(sr * ldk + sc) * 2u;
  const char* Kc0 = (const char*)Kh; const char* Vc0 = (const char*)Vh;
  const size_t tstep = (size_t)64 * ldk * 2, hstep = (size_t)32 * ldk * 2;
  struct { bf16x8 vs0, vs1, ks0, ks1; } sr_[1];
#define SLOAD(i, jt) do { const char* vb_ = Vc0 + (size_t)(jt) * tstep; const char* kb_ = Kc0 + (size_t)(jt) * tstep; unsigned lo_ = lofs; asm volatile("" : "+v"(lo_));   \
    sr_[i].vs0 = ld_off<bf16x8>(vb_, lo_); sr_[i].vs1 = ld_off<bf16x8>(vb_ + hstep, lo_); sr_[i].ks0 = ld_off<bf16x8>(kb_, lo_); sr_[i].ks1 = ld_off<bf16x8>(kb_ + hstep, lo_); } while (0)
#define SWRITE(b, i) do { *(bf16x8*)((char*)V_lds + (b) * SHM_V + vst0) = sr_[i].vs0;          \
    *(bf16x8*)((char*)V_lds + (b) * SHM_V + vst1) = sr_[i].vs1; int kc = sc * 2;               \
    *(bf16x8*)((char*)K_lds + (b) * SHM_K + KSWZ(sr, kc)) = sr_[i].ks0;                       \
    *(bf16x8*)((char*)K_lds + (b) * SHM_K + KSWZ(32 + sr, kc)) = sr_[i].ks1; } while (0)
#define SWAIT() asm volatile("s_waitcnt vmcnt(0)" ::: "memory")
  f32x16 pA0, pA1, pB0, pB1; bf16x8 pa0, pa1, pa2, pa3;
  f32x16 seed; for (int r = 0; r < 16; ++r) seed[r] = negM; asm volatile("" : "+v"(seed));
  constexpr int SE = 0, SO = 0;
  SLOAD(SE, 0); asm volatile("s_waitcnt vmcnt(0)" ::: "memory"); SWRITE(0, SE); __syncthreads();
  qkt(pA0, pA1, K_lds, qr, r32, hi, seed); partialSM(pA0);
  SLOAD(SO, 1);
  SWAIT(); SWRITE(1, SO); __syncthreads();
  for (int j = 1; j + 1 < NT; j += 2) {
    SBAR(); qkt(pB0, pB1, (bf16_t*)((char*)K_lds + SHM_K), qr, r32, hi, seed);
    finishSM(pA0, pA1, l_reg, pa0, pa1, pa2, pa3); SBAR();
    SLOAD(SO, j + 1); SBAR();
    pv_d0(o, vb0, pa0, pa1, pa2, pa3); partialSM(pB0);
    __syncthreads(); SWAIT(); SWRITE(0, SE);
    __syncthreads();
    SBAR(); qkt(pA0, pA1, K_lds, qr, r32, hi, seed);
    finishSM(pB0, pB1, l_reg, pa0, pa1, pa2, pa3); SBAR();
    SLOAD(SE, j + 2); SBAR();
    pv_d0(o, vb0 + (int)SHM_V, pa0, pa1, pa2, pa3); partialSM(pA0);
    __syncthreads(); SWAIT(); SWRITE(1, SO);
    __syncthreads();
  }
  SBAR(); qkt(pB0, pB1, (bf16_t*)((char*)K_lds + SHM_K), qr, r32, hi, seed);
  finishSM(pA0, pA1, l_reg, pa0, pa1, pa2, pa3); SBAR();
  pv_d0(o, vb0, pa0, pa1, pa2, pa3); partialSM(pB0);
  __syncthreads();
  finishSM(pB0, pB1, l_reg, pa0, pa1, pa2, pa3); SBAR();
  pv_d0(o, vb0 + (int)SHM_V, pa0, pa1, pa2, pa3);
  { auto rr = __builtin_amdgcn_permlane32_swap(__float_as_uint(l_reg), __float_as_uint(l_reg), false, false); l_reg = __uint_as_float(rr[0]) + __uint_as_float(rr[1]); }
  const float rl = __builtin_amdgcn_rcpf(l_reg);
  char* Ow = (char*)(Ob + (long)(wid * QBLK) * ldo);
  int te_ = threadIdx.x; asm volatile("" : "+v"(te_));
  const unsigned oofs = (unsigned)((te_ & 31) * ldo + 8 * ((te_ >> 5) & 1)) * 2u;
#pragma unroll
  for (int d0 = 0; d0 < 4; ++d0)
#pragma unroll
    for (int k = 0; k < 4; k += 2) {
      const unsigned a0 = cvt_pk_bf16(o[d0][4 * k + 0] * rl, o[d0][4 * k + 1] * rl), a1 = cvt_pk_bf16(o[d0][4 * k + 2] * rl, o[d0][4 * k + 3] * rl);
      const unsigned b0 = cvt_pk_bf16(o[d0][4 * k + 4] * rl, o[d0][4 * k + 5] * rl), b1 = cvt_pk_bf16(o[d0][4 * k + 6] * rl, o[d0][4 * k + 7] * rl);
      auto s0 = __builtin_amdgcn_permlane32_swap(a0, b0, false, false); auto s1 = __builtin_amdgcn_permlane32_swap(a1, b1, false, false);
      u32x4 w = {s0[0], s1[0], s0[1], s1[1]};
      st_off(Ow, oofs + (unsigned)(d0 * 32 + 8 * k) * 2u, w); }
  __syncthreads();
#undef SLOAD
#undef SWAIT
}
__device__ __forceinline__ void attn_na(const bf16_t* __restrict__ Qb, const bf16_t* __restrict__ Kh, const bf16_t* __restrict__ Vh, bf16_t* __restrict__ Ob,
                                        int ldq, int ldk, int ldo, char* lds, int na_lo, int na_r0, const float* rpb, float qkbound) {
  int tid = threadIdx.x; asm volatile("" : "+v"(tid));
  const int wid = tid >> 6, lane = tid & 63, r32 = lane & 31, hi = lane >> 5;
  bf16_t* V_lds = (bf16_t*)lds; bf16_t* K_lds = (bf16_t*)(lds + 2 * SHM_V);
  float* ws = (float*)(lds + 2 * SHM_V + 2 * SHM_K) + wid * 64; float* li_l = ws;
  float* bias_l = (float*)(lds + SHM_BIAS);
  const int rq = na_r0 + (wid >> 1), cq = 32 * (wid & 1) + r32;
  const int r0q = min(max(rq - 4, 0), 248), c0q = min(max(cq - 8, 0), 48);
  const int r0u = __builtin_amdgcn_readfirstlane(r0q);
  if (tid < 465) bias_l[tid] = rpb[tid] * 1.4426950408889634f;
  float bmax = 0.f;
#pragma unroll
  for (int i = 0; i < 8; ++i) { const int idx = lane + 64 * i; bmax = fmaxf(bmax, idx < 465 ? fabsf(rpb[idx]) : 0.f); }
#pragma unroll
  for (int o_ = 1; o_ < 64; o_ <<= 1) bmax = fmaxf(bmax, __int_as_float(__builtin_amdgcn_ds_bpermute((lane ^ o_) << 2, __float_as_int(bmax))));
  const float negM = -(qkbound * (SCALE * 1.4426950408889634f) + bmax * 1.4426950408889634f);
  float l_reg = 0; f32x16 o[4] = {}; bf16x8 qr[8];
  const bf16_t* Qw = Qb + (long)(wid * QBLK + r32) * ldq + hi * 8;
#pragma unroll
  for (int d0 = 0; d0 < 8; ++d0) qr[d0] = *reinterpret_cast<const bf16x8*>(Qw + d0 * 16);
  const int sr = tid >> 4, sc = (tid & 15) * 8, vst0 = v_st(sr, sc), vst1 = v_st(32 + sr, sc);
  const int vb0 = (int)(uintptr_t)V_lds + v_rd_base(lane);
  const unsigned lofs = (unsigned)(sr * ldk + sc) * 2u;
  const char* Kc0 = (const char*)Kh; const char* Vc0 = (const char*)Vh;
  const size_t rstep = (size_t)ldk * 2, hstep = (size_t)32 * ldk * 2;
  bf16x8 vs0, vs1, ks0, ks1;
#define KROW(j) ((j) < 4 ? SEQ + 64 * (j) : 64 * (na_lo + (j) - 4))
#define NLOAD(jt) do { const size_t ko_ = (size_t)KROW(jt) * rstep; unsigned lo_ = lofs; asm volatile("" : "+v"(lo_)); vs0 = ld_off<bf16x8>(Vc0 + ko_, lo_); vs1 = ld_off<bf16x8>(Vc0 + ko_ + hstep, lo_); ks0 = ld_off<bf16x8>(Kc0 + ko_, lo_); ks1 = ld_off<bf16x8>(Kc0 + ko_ + hstep, lo_); } while (0)
#define NWRITE(b) do { *(bf16x8*)((char*)V_lds + (b) * SHM_V + vst0) = vs0; *(bf16x8*)((char*)V_lds + (b) * SHM_V + vst1) = vs1; int kc = sc * 2;               \
    *(bf16x8*)((char*)K_lds + (b) * SHM_K + KSWZ(sr, kc)) = ks0; *(bf16x8*)((char*)K_lds + (b) * SHM_K + KSWZ(32 + sr, kc)) = ks1; } while (0)
  NLOAD(0); asm volatile("s_waitcnt vmcnt(0)" ::: "memory"); NWRITE(0); __syncthreads();
  for (int j = 0; j < 16; ++j) {
    const int b = j & 1;
    if (j + 1 < 16) NLOAD(j + 1);
    const int kr_ = na_lo + j - 4;
    if (j < 4 || (kr_ >= r0u && kr_ <= r0u + 7)) {
      f32x16 p0, p1; bf16x8 pa0, pa1, pa2, pa3;
      SBAR(); qkt(p0, p1, (bf16_t*)((char*)K_lds + b * SHM_K), qr, r32, hi, f32x16{});
      if (j >= 4) na_mask(p0, p1, kr_, rq, r0q, cq, c0q, bias_l, hi);
      for (int r = 0; r < 16; ++r) p0[r] += negM; for (int r = 0; r < 16; ++r) p1[r] += negM;
      partialSM(p0);
      finishSM(p0, p1, l_reg, pa0, pa1, pa2, pa3); SBAR();
      pv_d0(o, vb0 + b * (int)SHM_V, pa0, pa1, pa2, pa3);
    }
    if (j + 1 < 16) { asm volatile("s_waitcnt vmcnt(0)" ::: "memory"); NWRITE(b ^ 1); }
    __syncthreads();
  }
  { auto rr = __builtin_amdgcn_permlane32_swap(__float_as_uint(l_reg), __float_as_uint(l_reg), false, false); l_reg = __uint_as_float(rr[0]) + __uint_as_float(rr[1]); }
  const float rl = __builtin_amdgcn_rcpf(l_reg);
  char* Ow = (char*)(Ob + (long)(wid * QBLK) * ldo);
  int te_ = threadIdx.x; asm volatile("" : "+v"(te_));
  const unsigned oofs = (unsigned)((te_ & 31) * ldo + 8 * ((te_ >> 5) & 1)) * 2u;
#pragma unroll
  for (int d0 = 0; d0 < 4; ++d0)
#pragma unroll
    for (int k = 0; k < 4; k += 2) {
      const unsigned a0 = cvt_pk_bf16(o[d0][4 * k + 0] * rl, o[d0][4 * k + 1] * rl), a1 = cvt_pk_bf16(o[d0][4 * k + 2] * rl, o[d0][4 * k + 3] * rl);
      const unsigned b0 = cvt_pk_bf16(o[d0][4 * k + 4] * rl, o[d0][4 * k + 5] * rl), b1 = cvt_pk_bf16(o[d0][4 * k + 6] * rl, o[d0][4 * k + 7] * rl);
      auto s0 = __builtin_amdgcn_permlane32_swap(a0, b0, false, false); auto s1 = __builtin_amdgcn_permlane32_swap(a1, b1, false, false);
      u32x4 w = {s0[0], s1[0], s0[1], s1[1]};
      st_off(Ow, oofs + (unsigned)(d0 * 32 + 8 * k) * 2u, w); }
  __syncthreads();
#undef KROW
#undef NLOAD
#undef NWRITE
#undef SWRITE
}
}

struct Args { const float* in[25]; float* out; unsigned char* ws; int ph_lo, ph_hi; };
enum { I_X = 0, I_C, I_CTX, I_CCTX, I_WADA, I_BADA, I_NORM1, I_WIN, I_CONVW, I_NAQG, I_NAKG, I_RPB, I_GQG, I_GKG, I_WCO, I_WFO, I_WNO, I_WGO, I_WGATE, I_BGATE, I_WO, I_NORM2, I_WUP, I_FCW, I_WDOWN };

__device__ __forceinline__ int rowmap(int mode, int n) {
    if (mode == 1) { const int zc = n < 1536 ? n : n - 512;
        if (zc < 3072 || zc >= 4352) return zc;
        const int d = zc & 127, nn = d >> 6, p = d & 63; return (zc & ~127) + 32 * (p >> 4) + 8 * ((p >> 2) & 3) + 4 * nn + (p & 3); }
    if (mode == 2) { const int b = n >> 11, d = n & 2047; return 256 * (d >> 6) + 128 * (b & 1) + 32 * ((d >> 4) & 3) + 8 * (2 * ((d >> 3) & 1) + (b >> 1)) + (d & 7); }
    if (mode == 3) { const int g = n >= FF, ch = g ? n - FF : n; return 256 * (ch >> 7) + 128 * g + (ch & 127); }
    return n;
}
__device__ __forceinline__ void transpose_item(const float* W, int ldw, int k0, int n0, bf16_t* WT, int ldd, int koff, int mode, LAS float* scr, int lane) {
    const int kk = lane >> 3, q = lane & 7;
    f32x4 v[16];
#pragma unroll
    for (int h = 0; h < 2; ++h)
#pragma unroll
        for (int i = 0; i < 8; ++i) v[h * 8 + i] = *(const f32x4*)(W + (size_t)(k0 + 8 * i + kk) * ldw + n0 + 32 * h + 4 * q);
    const int c = lane & 7;
#pragma unroll
    for (int h = 0; h < 2; ++h) {
#pragma unroll
        for (int i = 0; i < 8; ++i)
#pragma unroll
            for (int e = 0; e < 4; ++e) scr[(8 * i + kk) * 33 + 4 * q + e] = v[h * 8 + i][e];
        LDS_WAIT(); asm volatile("" ::: "memory");
#pragma unroll
        for (int j = 0; j < 4; ++j) { const int n = (lane >> 3) + 8 * j; const LAS float* s = scr + (8 * c) * 33 + n;
            const float ws_ = (mode == 2) ? GATE_PRESCALE : 1.0f;
            u32x4 o; o.x = cvt_pk_bf16(s[0 * 33] * ws_, s[1 * 33] * ws_); o.y = cvt_pk_bf16(s[2 * 33] * ws_, s[3 * 33] * ws_); o.z = cvt_pk_bf16(s[4 * 33] * ws_, s[5 * 33] * ws_); o.w = cvt_pk_bf16(s[6 * 33] * ws_, s[7 * 33] * ws_);
            *(u32x4*)(WT + (size_t)rowmap(mode, n0 + 32 * h + n) * ldd + koff + k0 + 8 * c) = o; }
        LDS_WAIT(); asm volatile("" ::: "memory");
    }
}
__device__ __forceinline__ void copy_item(const float* W, int ldw, int k0, int n0, bf16_t* dst, int ldd, int nd0, int lane) {
#pragma unroll 8
    for (int i = 0; i < 32; ++i) { const int kk = 2 * i + (lane >> 5); const float v = W[(size_t)(k0 + kk) * ldw + n0 + (lane & 31)];
        dst[(size_t)(k0 + kk) * ldd + nd0 + (lane & 31)] = (bf16_t)(cvt_pk_bf16(v, 0.f) & 0xffffu); }
}

__device__ __forceinline__ const void* uptr(const LAS unsigned long long* tab, int i) {
    const unsigned long long v = tab[i]; const unsigned lo = __builtin_amdgcn_readfirstlane((unsigned)v), hi = __builtin_amdgcn_readfirstlane((unsigned)(v >> 32));
    return (const void*)(const GAS void*)(((unsigned long long)hi << 32) | lo); }
__device__ __forceinline__ unsigned noff(int lane, int j) { return (unsigned)(j >> 1) * 2048u + (unsigned)lane * 32u + (unsigned)(j & 1) * 16u; }
__device__ __forceinline__ void st_wt16(void* base, unsigned off, u32x4 v) {
    asm volatile("global_store_dwordx4 %0, %1, %2 sc1\n\ts_nop 1" :: "v"(off), "v"(v), "s"(base) : "memory"); }
__device__ __forceinline__ void norm_prep(const float* gain, const float* mod, int shi, int lane, f32x4 (&G)[8], f32x4 (&S)[8]) {
#pragma unroll
    for (int j = 0; j < 8; ++j) { const unsigned o = noff(lane, j); const f32x4 g = ld_off<f32x4>(gain, o), sc = ld_off<f32x4>(mod + shi + D, o); S[j] = ld_off<f32x4>(mod + shi, o); G[j] = g * (sc + 1.0f); }
}
__device__ __forceinline__ void norm_finish(f32x4 (&v)[8], const f32x4 (&G)[8], const f32x4 (&S)[8], bf16_t* orow, int lane) {
    float ss = 0.f;
#pragma unroll
    for (int j = 0; j < 8; ++j) ss += (v[j].x * v[j].x + v[j].y * v[j].y) + (v[j].z * v[j].z + v[j].w * v[j].w);
    const float rstd = 1.0f / sqrtf(wave_sum(ss, lane) * (1.0f / D) + EPS);
#pragma unroll
    for (int k = 0; k < 4; ++k) { const f32x4 o0 = (v[2 * k] * rstd) * G[2 * k] + S[2 * k], o1 = (v[2 * k + 1] * rstd) * G[2 * k + 1] + S[2 * k + 1];
        u32x4 w; w.x = cvt_pk_bf16(o0.x, o0.y); w.y = cvt_pk_bf16(o0.z, o0.w); w.z = cvt_pk_bf16(o1.x, o1.y); w.w = cvt_pk_bf16(o1.z, o1.w);
        st_wt16(orow, (unsigned)k * 1024u + (unsigned)lane * 16u, w); }
}
__device__ __forceinline__ void norm_lat_rows(const void* hL, int hbf, int lr0, int nlat, const float* gain, const float* modL, int shi, bf16_t* XN, int lane) {
    f32x4 G[8], S[8]; norm_prep(gain, modL, shi, lane, G, S);
    for (int i = 0; i < nlat; ++i) { const int r = lr0 + i; const char* xrow = (const char*)hL + (size_t)r * D * (hbf ? 2 : 4); f32x4 v[8];
        if (hbf) {
#pragma unroll
            for (int k = 0; k < 4; ++k) { const u32x4 w = ld_off<u32x4>(xrow, (unsigned)k * 1024u + (unsigned)lane * 16u);
                v[2 * k] = (f32x4){bf_lo(w.x), bf_hi(w.x), bf_lo(w.y), bf_hi(w.y)}; v[2 * k + 1] = (f32x4){bf_lo(w.z), bf_hi(w.z), bf_lo(w.w), bf_hi(w.w)}; }
        } else {
#pragma unroll
            for (int j = 0; j < 8; ++j) v[j] = ld_off<f32x4>(xrow, noff(lane, j)); }
        norm_finish(v, G, S, XN + (size_t)r * D, lane); }
}
__device__ __forceinline__ void norm_ctx_row(int crow, const float* cbase, const float* part, int ns, const float* cg, float* HC, const float* gain, const float* modC, int shi, bf16_t* XN, int lane) {
    const float* xrow = cbase + (size_t)crow * D; f32x4 v[8];
#pragma unroll
    for (int j = 0; j < 8; ++j) v[j] = ld_off<f32x4>(xrow, noff(lane, j));
    if (ns > 0) {
        f32x4 a[8];
#pragma unroll
        for (int j = 0; j < 8; ++j) a[j] = (f32x4){0.f, 0.f, 0.f, 0.f};
        int s = 0;
        for (; s + 2 <= ns; s += 2) { const float* p0 = part + ((size_t)s * 256 + crow) * D; const float* p1 = p0 + (size_t)256 * D; f32x4 t[2][8];
#pragma unroll
            for (int j = 0; j < 8; ++j) { t[0][j] = ld_off<f32x4>(p0, noff(lane, j)); t[1][j] = ld_off<f32x4>(p1, noff(lane, j)); }
#pragma unroll
            for (int j = 0; j < 8; ++j) a[j] += t[0][j] + t[1][j]; }
        for (; s < ns; ++s) { const float* p0 = part + ((size_t)s * 256 + crow) * D;
#pragma unroll
            for (int j = 0; j < 8; ++j) a[j] += ld_off<f32x4>(p0, noff(lane, j)); }
        float* hc = HC + (size_t)crow * D;
#pragma unroll
        for (int j = 0; j < 8; ++j) { v[j] += ld_off<f32x4>(cg, noff(lane, j)) * a[j]; st_off(hc, noff(lane, j), v[j]); }
    }
    f32x4 G[8], S[8]; norm_prep(gain, modC, shi, lane, G, S);
    norm_finish(v, G, S, XN + (size_t)(SEQ + crow) * D, lane);
}
template <bool CTX, int NR>
__device__ __forceinline__ void ffn_conv_rows(const bf16_t* U, const float* PU, const float* fw, bf16_t* A, int t0, int ch, bool hasp, bool hasn) {
    float wa[3][8], wg[3][8];
#pragma unroll
    for (int dd = 0; dd < 3; ++dd)
#pragma unroll
        for (int e = 0; e < 8; ++e) { wa[dd][e] = fw[dd * ULD + ch + e]; wg[dd][e] = fw[dd * ULD + FF + ch + e]; }
    float pa[8], pg[8], ca[8], cg[8], na[8], ng[8];
#define LDROW(tr, AA, GG) do { if (CTX) { _Pragma("unroll") for (int e = 0; e < 8; ++e) { AA[e] = 0.f; GG[e] = 0.f; } \
        _Pragma("unroll") for (int s = 0; s < 4; ++s) { const float* pr = PU + ((size_t)s * 256 + (tr)) * ULD + 256 * (ch >> 7) + (ch & 127);   const f32x4 a0 = *(const f32x4*)pr, a1 = *(const f32x4*)(pr + 4), g0 = *(const f32x4*)(pr + 128), g1 = *(const f32x4*)(pr + 132); \
            _Pragma("unroll") for (int e = 0; e < 4; ++e) { AA[e] += a0[e]; AA[4 + e] += a1[e]; GG[e] += g0[e]; GG[4 + e] += g1[e]; } } } \
      else { const u32x4 xa = *(const u32x4*)(U + (size_t)(tr) * ULD + ch), xg = *(const u32x4*)(U + (size_t)(tr) * ULD + FF + ch); \
            _Pragma("unroll") for (int e = 0; e < 4; ++e) { AA[2 * e] = bf_lo(xa[e]); AA[2 * e + 1] = bf_hi(xa[e]); GG[2 * e] = bf_lo(xg[e]); GG[2 * e + 1] = bf_hi(xg[e]); } } } while (0)
#pragma unroll
    for (int e = 0; e < 8; ++e) { pa[e] = 0.f; pg[e] = 0.f; }
    if (hasp) LDROW(t0 - 1, pa, pg);
    LDROW(t0, ca, cg);
#pragma unroll
    for (int i = 0; i < NR; ++i) {
        const int t = t0 + i; const bool okn = (i < NR - 1) || hasn;
#pragma unroll
        for (int e = 0; e < 8; ++e) { na[e] = 0.f; ng[e] = 0.f; }
        if (okn) LDROW(t + 1, na, ng);
        float ov[8];
#pragma unroll
        for (int e = 0; e < 8; ++e) { const float ua = pa[e] * wa[0][e] + ca[e] * wa[1][e] + na[e] * wa[2][e], ug = pg[e] * wg[0][e] + cg[e] * wg[1][e] + ng[e] * wg[2][e];
            ov[e] = ua * __builtin_amdgcn_rcpf(1.0f + __builtin_amdgcn_exp2f(-1.4426950408889634f * ua)) * ug; }
        u32x4 ow; ow.x = cvt_pk_bf16(ov[0], ov[1]); ow.y = cvt_pk_bf16(ov[2], ov[3]); ow.z = cvt_pk_bf16(ov[4], ov[5]); ow.w = cvt_pk_bf16(ov[6], ov[7]);
        if (CTX) { const unsigned long long w0 = (unsigned long long)ow.x | ((unsigned long long)ow.y << 32), w1 = (unsigned long long)ow.z | ((unsigned long long)ow.w << 32);
            __hip_atomic_store((unsigned long long*)(A + (size_t)t * FF + ch), w0, __ATOMIC_RELAXED, __HIP_MEMORY_SCOPE_AGENT); __hip_atomic_store((unsigned long long*)(A + (size_t)t * FF + ch + 4), w1, __ATOMIC_RELAXED, __HIP_MEMORY_SCOPE_AGENT); }
        else *(u32x4*)(A + (size_t)t * FF + ch) = ow;
#pragma unroll
        for (int e = 0; e < 8; ++e) { pa[e] = ca[e]; pg[e] = cg[e]; ca[e] = na[e]; cg[e] = ng[e]; }
    }
#undef LDROW
}
__device__ __forceinline__ float wave_absmax128(const float* g, int lane) {
    float m = fmaxf(fabsf(g[lane]), fabsf(g[lane + 64]));
#pragma unroll
    for (int o = 1; o < 64; o <<= 1) m = fmaxf(m, __int_as_float(__builtin_amdgcn_ds_bpermute((lane ^ o) << 2, __float_as_int(m))));
    return m;
}
__device__ __forceinline__ float silu_f(float x) { return x / (1.0f + __expf(-x)); }

__global__ void __launch_bounds__(NWAVES * 64, 2) fwd(Args args) {
    extern __shared__ __attribute__((aligned(16))) unsigned char lds_raw[];
    LAS unsigned char* lds = (LAS unsigned char*)lds_raw;
    const int tid0 = threadIdx.x, wave = __builtin_amdgcn_readfirstlane(tid0 >> 6);
    const int G = gridDim.x, bx = blockIdx.x;
#define LAUNDER_TID() int tid = tid0; asm volatile("" : "+v"(tid)); const int lane = tid & 63; (void)lane; unsigned long long wsi_ = (unsigned long long)args.ws, outi_ = (unsigned long long)args.out; int bxr = bx; asm volatile("" : "+s"(wsi_), "+s"(outi_), "+s"(bxr)); unsigned char* ws = (unsigned char*)(GAS unsigned char*)wsi_; float* outp = (float*)(GAS float*)outi_; (void)outp; (void)bxr
    const int gw = bx * NWAVES + wave, NGW = G * NWAVES;
    unsigned* ctl = (unsigned*)(args.ws + WS_CTL);
    for (int u = tid0; u < (LDS_BYTES - LDSCTL_OFF) / 4; u += NWAVES * 64) ((LAS unsigned*)(lds + LDSCTL_OFF))[u] = 0u;
    __syncthreads();
    LAS unsigned long long* ptab = (LAS unsigned long long*)(lds + PTAB_OFF);
    if (tid0 == 0) {
#define PT(i) ptab[i] = (unsigned long long)args.in[i]
        PT(0); PT(1); PT(2); PT(3); PT(4); PT(5); PT(6); PT(7); PT(8); PT(9); PT(10); PT(11); PT(12); PT(13); PT(14); PT(15); PT(16); PT(17); PT(18); PT(19); PT(20); PT(21); PT(22); PT(23); PT(24);
#undef PT
    }
    __syncthreads();
#define INP(i) ((const float*)uptr(ptab, (i)))
#if MK_PER_PHASE
#define GRID_BAR() do { } while (0)
#else
    (void)xcd_barrier_post(ctl + CW_BAR, (volatile LAS unsigned*)(lds + MISC_OFF) + 8);
#define GRID_BAR() do { XcdBarrier bar_; bar_.bar = (unsigned*)(args.ws + WS_CTL) + CW_BAR; bar_.x = xb_xcc_id(); bar_.st = (volatile LAS unsigned*)(lds + MISC_OFF) + 8; xcd_barrier(bar_); } while (0)
#endif
    const int lo = args.ph_lo, hi = args.ph_hi;
#define IN(k) (lo <= (k) && (k) < hi)
#define SEAM(k) do { if (IN((k) + 1)) GRID_BAR(); } while (0)

#define XN ((bf16_t*)(ws + WS_XN))
#define Z ((bf16_t*)(ws + WS_Z))
#define XT ((bf16_t*)(ws + WS_XT))
#define YT ((bf16_t*)(ws + WS_YT))
#define YS ((bf16_t*)(ws + WS_YS))
#define PB ((bf16_t*)(ws + WS_P))
#define HB ((bf16_t*)(ws + WS_HB))
#define MG ((bf16_t*)(ws + WS_MG))
#define ACT ((bf16_t*)(ws + WS_ACT))
#define XTC ((bf16_t*)(ws + WS_XTC))
#define HC ((float*)(ws + WS_HC))
#define MOD ((float*)(ws + WS_MOD))
#define ADAP ((float*)(ws + WS_ADAP))
#define D1 ((bf16_t*)(ws + WS_D1))
#define DCT ((bf16_t*)(ws + WS_DCT))
#define DCTX ((bf16_t*)(ws + WS_DCTX))
#define TW ((f32x2*)(ws + WS_TW))
#define RT ((f32x2*)(ws + WS_RT))
#define CT ((f32x2*)(ws + WS_CT))
#define OUTP (outp)
#define wl (ws + WS_W + (size_t)l * WL_STRIDE)
#define modL ((const float*)(ws + WS_MOD) + (size_t)(l * 2 + 0) * NADA)
#define modC ((const float*)(ws + WS_MOD) + (size_t)(l * 2 + 1) * NADA)
#define hL ((l == 0) ? INP(I_X) : (const float*)outp)
#define hCx ((l == 0) ? INP(I_CTX) : (const float*)HC)

    if (IN(0)) { PROBE_REP(0) { LAUNDER_TID();
        LAS float* sv = (LAS float*)(lds + 98304);
        for (int i = tid; i < 2048; i += NWAVES * 64) { sv[i] = silu_f(INP(I_C)[i]); sv[2048 + i] = silu_f(INP(I_CCTX)[i]); }
        __syncthreads();
        for (int it = gw; it < 4 * 32 * 48; it += NGW) {
            const int l = it / 1536, kc = (it / 48) % 32, cc = it % 48, col = cc * 256 + lane * 4;
            const float* Wp = INP(I_WADA) + ((size_t)l * 2048 + kc * 64) * NADA + col;
            f32x4 a0 = (f32x4){0.f, 0.f, 0.f, 0.f}, a1 = a0;
#pragma unroll 16
            for (int k = 0; k < 64; ++k) { const f32x4 w = *(const f32x4*)(Wp + (size_t)k * NADA); const float s0 = sv[kc * 64 + k], s1 = sv[2048 + kc * 64 + k]; a0 += w * s0; a1 += w * s1; }
            float* pp = ADAP + ((size_t)(l * 32 + kc) * 2) * NADA + col;
            *(f32x4*)pp = a0; *(f32x4*)(pp + NADA) = a1;
        }
        LAS float* scr = (LAS float*)(lds + wave * 8448);
        constexpr int I_IN = 32 * 80, I_GATE = 32 * 128, I_O = 32 * 32, I_UP = 32 * 176, I_DOWN = 88 * 32, I_OC = 8 * 32, I_OG = 16 * 32;
        constexpr int I_LAYER = I_IN + I_GATE + I_O + I_UP + I_DOWN + 3 * I_OC + I_OG;
        for (int it = gw; it < DEPTH * I_LAYER; it += NGW) {
            const int l = it / I_LAYER; int r = it % I_LAYER;
            unsigned char* wlp = ws + WS_W + (size_t)l * WL_STRIDE;
            if (r < I_IN) { const int kb = r / 80, nb = r % 80; const float* W = INP(I_WIN) + (size_t)l * 2048 * NIN;
                if (nb >= 24 && nb < 32) { copy_item(W, NIN, 64 * kb, 64 * nb, (bf16_t*)(wlp + WL_INF), 512, 64 * nb - 1536, lane); copy_item(W, NIN, 64 * kb, 64 * nb + 32, (bf16_t*)(wlp + WL_INF), 512, 64 * nb + 32 - 1536, lane); }
                else transpose_item(W, NIN, 64 * kb, 64 * nb, (bf16_t*)(wlp + WL_IN), 2048, 0, 1, scr, lane);
                continue; } r -= I_IN;
            if (r < I_GATE) { transpose_item(INP(I_WGATE) + (size_t)l * 2048 * 8192, 8192, 64 * (r / 128), 64 * (r % 128), (bf16_t*)(wlp + WL_GATE), 2048, 0, 2, scr, lane); continue; } r -= I_GATE;
            if (r < I_O) { transpose_item(INP(I_WO) + (size_t)l * 2048 * 2048, 2048, 64 * (r / 32), 64 * (r % 32), (bf16_t*)(wlp + WL_O), 2048, 0, 0, scr, lane); continue; } r -= I_O;
            if (r < I_UP) { transpose_item(INP(I_WUP) + (size_t)l * 2048 * ULD, ULD, 64 * (r / 176), 64 * (r % 176), (bf16_t*)(wlp + WL_UP), 2048, 0, 3, scr, lane); continue; } r -= I_UP;
            if (r < I_DOWN) { transpose_item(INP(I_WDOWN) + (size_t)l * FF * 2048, 2048, 64 * (r / 32), 64 * (r % 32), (bf16_t*)(wlp + WL_DOWN), FF, 0, 0, scr, lane); continue; } r -= I_DOWN;
            if (r < I_OC) { transpose_item(INP(I_WCO) + (size_t)l * 512 * 2048, 2048, 64 * (r / 32), 64 * (r % 32), (bf16_t*)(wlp + WL_OUT), YLD, 0, 0, scr, lane); continue; } r -= I_OC;
            if (r < I_OC) { transpose_item(INP(I_WFO) + (size_t)l * 512 * 2048, 2048, 64 * (r / 32), 64 * (r % 32), (bf16_t*)(wlp + WL_OUT), YLD, 512, 0, scr, lane); continue; } r -= I_OC;
            if (r < I_OC) { transpose_item(INP(I_WNO) + (size_t)l * 512 * 2048, 2048, 64 * (r / 32), 64 * (r % 32), (bf16_t*)(wlp + WL_OUT), YLD, 1024, 0, scr, lane); continue; } r -= I_OC;
            transpose_item(INP(I_WGO) + (size_t)l * 1024 * 2048, 2048, 64 * (r / 32), 64 * (r % 32), (bf16_t*)(wlp + WL_OUT), YLD, 1536, 0, scr, lane);
        }
        const int gt = bx * (NWAVES * 64) + tid, NGT = G * NWAVES * 64;
        for (int i = gt; i < 256 * 256; i += NGT) { const int n = i >> 8, k = i & 255, ro = n >> 7, k1 = n & 127, ri = k >> 7, tA = k & 127;
            const float x = (float)((k1 * tA) & 127) * (1.0f / 64.0f); const float cs = cospif(x), sn = sinpif(x);
            const float v = ro == 0 ? (ri == 0 ? cs : sn) : (ri == 0 ? -sn : cs); D1[i] = (bf16_t)(cvt_pk_bf16(v, 0.f) & 0xffffu); }
        for (int i = gt; i < 1024 * 512; i += NGT) { const int m = i >> 9, cf = i & 511, g = m >> 8, ri = (m >> 7) & 1, cp = m & 127, g2 = cf >> 7, c = cf & 127;
            const float x = (float)((cp * c) & 127) * (1.0f / 64.0f); const float v = (g == g2) ? (ri == 0 ? cospif(x) : -sinpif(x)) : 0.f; DCT[i] = (bf16_t)(cvt_pk_bf16(v, 0.f) & 0xffffu); }
        for (int i = gt; i < 256 * 512; i += NGT) { const int k = i >> 9, kk = i & 511, ri = kk >> 8, t = kk & 255;
            const float x = (float)((k * t) & 255) * (1.0f / 128.0f); const float v = ri == 0 ? cospif(x) : sinpif(x); DCTX[i] = (bf16_t)(cvt_pk_bf16(v, 0.f) & 0xffffu); }
        for (int i = gt; i < 128 * 128; i += NGT) { const int k1 = i >> 7, tB = i & 127; const float x = (float)(k1 * tB) * (1.0f / 8192.0f); TW[i] = (f32x2){cospif(x), sinpif(x)}; }
        for (int i = gt; i < 256 * 32 + 64 * 32; i += NGT) { const bool isr = i < 256 * 32; const int ii = isr ? i : i - 256 * 32; const int p = ii >> 5, j = ii & 31;
            const float inv = powf(10000.0f, -(float)j / 32.0f); const float ang = (float)p * inv; float sn, cs; sincosf(ang, &sn, &cs);
            if (isr) RT[ii] = (f32x2){cs, sn}; else CT[ii] = (f32x2){cs, sn}; }
        PROBE_END(); } SEAM(0);
    }
    if (IN(1)) { PROBE_REP(1) { LAUNDER_TID();
        const int gt = bx * (NWAVES * 64) + tid, NGT = G * NWAVES * 64;
        for (int i = gt; i < DEPTH * 2 * NADA; i += NGT) { const int l = i / (2 * NADA), v = (i / NADA) & 1, col = i % NADA;
            float s = INP(I_BADA)[l * NADA + col];
#pragma unroll
            for (int kc = 0; kc < 32; ++kc) s += ADAP[((size_t)(l * 32 + kc) * 2 + v) * NADA + col];
            MOD[i] = s; }
        pg8::ProbFold P{(const char*)DCT, (const char*)(ws + WS_W + WL_INF), 512, 512, 128L * 512 * 2, 128L * 512 * 2, 256L * 512 * 2, 256L * 512 * 2, (long)WL_STRIDE};
        pg8::StaticOrder S; S.init(16, 8, G, bx);
        pg8::EpiPlain E{(bf16_t*)(ws + WS_W + WL_FT), 2048, 0.08838834764831845f, 4, WL_STRIDE / 2};
        pg8::gemm_phase(lds, P, S, E);
        PROBE_END(); } SEAM(1);
    }

    for (int l = 0; l < DEPTH; ++l) {
        const int pb = 2 + 8 * l;
        unsigned* tcnt = (unsigned*)(args.ws + WS_CTL) + CW_TEAM + (size_t)(l * NSTEP) * 65 * 64;
#define TCNT(s, j) (tcnt + ((s) * 65 + (j)) * 64)
        unsigned* ttmo = (unsigned*)(args.ws + WS_CTL) + CW_BAR + XB_TMO;
        const bool lastl = (l == DEPTH - 1);
        const int nPan = lastl ? 64 : 65;

        if (IN(pb + 0)) { LAUNDER_TID();
            const int mypm = 8 * (bxr & 7) + ((bxr >> 3) & 7), myq = (bxr >> 6) & 3;
            { const bool hv = (l != 0); norm_lat_rows(l == 0 ? (const void*)INP(I_X) : (const void*)HB, l != 0, 256 * mypm + 64 * myq + (hv ? 9 : 8) * wave, hv ? (wave < 7 ? 9 : 1) : 8, INP(I_NORM1) + l * D, modL, 0, XN, lane); }
            if (wave == 7 && bxr < CTXL) norm_ctx_row(bx, hCx, (const float*)(ws + WS_PDN), l == 0 ? 0 : 11, MOD + (size_t)((l - 1) * 2 + 1) * NADA + 5 * D, HC, INP(I_NORM1) + l * D, modC, 0, XN, lane);
            team_arrive(tcnt + (0 * 65 + mypm) * 64, tcnt + (0 * 65 + 64) * 64);
            team_wait(tcnt + (0 * 65 + mypm) * 64, 4u, ttmo);
            { pg8::ProbPlain P{(const char*)XN, (const char*)(wl + WL_IN), 2048, 2048, 128L * 2048 * 2, 128L * 2048 * 2, 256L * 2048 * 2, 256L * 2048 * 2, 32};
              pg8::StaticOrder S; S.init(64, 18, G, bx);
              pg8::EpiZ E{Z, INP(I_NAQG) + l * 128, INP(I_NAKG) + l * 128, INP(I_GQG) + l * 128, INP(I_GKG) + l * 128, RT, CT, (LAS float*)(lds + HALO_OFF), 0};
              pg8::gemm_phase(lds, P, S, E); }
            team_wait(tcnt + (0 * 65 + 64) * 64, (unsigned)G, ttmo);
            {
              pg8::ProbPlain P{(const char*)(wl + WL_FT), (const char*)XN, 2048, 128 * 2048, 128L * 2048 * 2, 2048L * 2, 256L * 2048 * 2, 2L * 2048 * 2, 32};
              pg8::StaticOrder S; S.init(4, 64, G, (bxr + 104) % G); pg8::EpiF0 E{XT};
              pg8::gemm_phase(lds, P, S, E); }
            {
              pg8::ProbPlain P{(const char*)(XN + (size_t)SEQ * D), (const char*)(wl + WL_IN), 2048, 2048, 128L * 2048 * 2, 128L * 2048 * 2, 256L * 2048 * 2, 256L * 2048 * 2, 32};
              pg8::StaticOrder S; S.init(1, 18, G, (bxr + 92) % G);
              pg8::EpiZ E{Z + (size_t)SEQ * ZLD, INP(I_NAQG) + l * 128, INP(I_NAKG) + l * 128, INP(I_GQG) + l * 128, INP(I_GKG) + l * 128, RT, CT, (LAS float*)(lds + HALO_OFF), 1};
              pg8::gemm_phase(lds, P, S, E); }
            if (!lastl) {
              pg8::ProbPlain P{(const char*)(wl + WL_FT), (const char*)(XN + (size_t)SEQ * D), 2048, 2048, 128L * 2048 * 2, 128L * 2048 * 2, 256L * 2048 * 2, 256L * 2048 * 2, 32};
              pg8::StaticOrder S; S.init(4, 1, G, (bxr + 128) % G); pg8::EpiF0c E{XTC};
              pg8::gemm_phase(lds, P, S, E); }
            if (!lastl) {
              pg8::ProbPlain P{(const char*)(XN + (size_t)SEQ * D), (const char*)(wl + WL_GATE), 2048, 2048, 128L * 2048 * 2, 128L * 2048 * 2, 256L * 2048 * 2, 256L * 2048 * 2, 32};
              pg8::StaticOrder S; S.init(1, 32, G, (bxr + 124) % G); pg8::EpiPlain1 E{(bf16_t*)(ws + WS_GC), 8192, 1.0f, 0, 0};
              pg8::gemm_phase(lds, P, S, E); }
            SEAM(pb + 0);
        }
        if (IN(pb + 1)) { PROBE_REP(4) { LAUNDER_TID();
            const float* cw = INP(I_CONVW) + l * 3 * 512;
            const bool f1c_wg = !lastl && (bxr == 240 || bxr == 241);
            const int cgw = (bxr < 240 || lastl) ? gw : gw - 2 * NWAVES, cngw = lastl ? NGW : NGW - 2 * NWAVES;
            f32x4 cwt[3][2];
#pragma unroll
            for (int dd = 0; dd < 3; ++dd) { cwt[dd][0] = *(const f32x4*)(cw + dd * 512 + 8 * lane); cwt[dd][1] = *(const f32x4*)(cw + dd * 512 + 8 * lane + 4); }
            for (int r = f1c_wg ? MT : cgw; r < MT; r += cngw) {
                bf16_t* zr = (rep_ == 0 ? Z : PB) + (size_t)r * ZLD;     const bool lat = r < SEQ; const int grow = (r >> 6) & 255, gcol = r & 63; const int q = lane & 15;
                const bool hasp = (r != 0) && (r != SEQ), hasn = (r != SEQ - 1) && (r != MT - 1);
                const int ch = 8 * lane; float cx[3][8];
#pragma unroll
                for (int dd = 0; dd < 3; ++dd) {
                    const bool ok = dd == 1 || (dd == 0 ? hasp : hasn);
                    u32x4 xa = (u32x4){0u, 0u, 0u, 0u}, cg = xa;
                    if (ok) { const bf16_t* zz = zr + (long)(dd - 1) * ZLD; xa = *(const u32x4*)(zz + ch); cg = *(const u32x4*)(zz + 1024 + ch); }
#pragma unroll
                    for (int e = 0; e < 4; ++e) { cx[dd][2 * e] = bf_lo(xa[e]) * bf_lo(cg[e]); cx[dd][2 * e + 1] = bf_hi(xa[e]) * bf_hi(cg[e]); }
                }
                const u32x4 bgw = *(const u32x4*)(zr + 512 + ch); float ov[8];
#pragma unroll
                for (int e = 0; e < 8; ++e) { const float bgv = (e & 1) ? bf_hi(bgw[e >> 1]) : bf_lo(bgw[e >> 1]);
                    ov[e] = bgv * (cx[0][e] * cwt[0][e >> 2][e & 3] + cx[1][e] * cwt[1][e >> 2][e & 3] + cx[2][e] * cwt[2][e >> 2][e & 3]); }
                u32x4 ow; ow.x = cvt_pk_bf16(ov[0], ov[1]); ow.y = cvt_pk_bf16(ov[2], ov[3]); ow.z = cvt_pk_bf16(ov[4], ov[5]); ow.w = cvt_pk_bf16(ov[6], ov[7]);
                *(u32x4*)(YS + (size_t)r * YLD + ch) = ow;
            }
            __syncthreads();
            { pg8::ProbPlain P{(const char*)D1, (const char*)XT, 256, 256, 128L * 256 * 2, 128L * 256 * 2, 256L * 256 * 2, 256L * 256 * 2, 4};
              pg8::StaticOrder S; S.init(1, 256, G, bx); pg8::EpiF1s E{YT, TW, 0.08838834764831845f};
              pg8::gemm_phase(lds, P, S, E); }
            if (!lastl) {
              pg8::ProbPlain P{(const char*)XTC, (const char*)DCTX, 512, 512, 128L * 512 * 2, 128L * 512 * 2, 256L * 512 * 2, 256L * 512 * 2, 8};
              pg8::StaticOrder S; S.init(2, 1, G, (bxr + 16) % G); pg8::EpiF1c E{YS, 0.0625f};
              pg8::gemm_phase(lds, P, S, E); }
            PROBE_END(); } SEAM(pb + 1);
        }
        if (IN(pb + 2)) { PROBE_REP(5) { LAUNDER_TID();
            { pg8::ProbPlain P{(const char*)D1, (const char*)YT, 256, 256, 128L * 256 * 2, 128L * 256 * 2, 256L * 256 * 2, 256L * 256 * 2, 4};
              pg8::StaticOrder S; S.init(1, 256, G, bx); pg8::EpiF2s E{YS, 0.08838834764831845f};
              pg8::gemm_phase(lds, P, S, E); }
            __syncthreads();
            const float kC = att::SCALE * 1.4426950408889634f;
            const float qkb_g = __uint_as_float(__builtin_amdgcn_readfirstlane(__float_as_uint(129.3f * wave_absmax128(INP(I_GQG) + l * 128, lane) * wave_absmax128(INP(I_GKG) + l * 128, lane))));
            const float qkb_n = __uint_as_float(__builtin_amdgcn_readfirstlane(__float_as_uint(129.3f * wave_absmax128(INP(I_NAQG) + l * 128, lane) * wave_absmax128(INP(I_NAKG) + l * 128, lane))));
            const int ndense = lastl ? 512 : 524;
            for (int u = bx; u < ndense; u += G) {
                const bf16_t *Qp, *Kp, *Vp; bf16_t* Op; int NT;
                if (u < 512) { const int idx = u & 255, h = 4 * (u >> 8) + (idx & 3), qb = idx >> 2;
                    Qp = Z + (size_t)qb * 256 * ZLD + 3072 + h * 128; Kp = Z + 4096 + (h >> 2) * 128; Vp = Z + 4352 + (h >> 2) * 128; Op = YS + (size_t)qb * 256 * YLD + 1536 + h * 128; NT = MT / 64; }
                else if (u < 520) { const int h = u - 512; const bf16_t* zc = Z + (size_t)SEQ * ZLD;
                    Qp = zc + 3072 + h * 128; Kp = zc + 4096 + (h >> 2) * 128; Vp = zc + 4352 + (h >> 2) * 128; Op = YS + (size_t)SEQ * YLD + 1536 + h * 128; NT = 4; }
                else { const int h = u - 520; const bf16_t* zc = Z + (size_t)SEQ * ZLD;
                    Qp = zc + 1536 + h * 128; Kp = zc + 2048 + h * 128; Vp = zc + 2560 + h * 128; Op = YS + (size_t)SEQ * YLD + 1024 + h * 128; NT = 4; }
                att::attn_body(Qp, Kp, Vp, Op, NT, ZLD, ZLD, YLD, (char*)lds_raw, -(u < 520 ? qkb_g : qkb_n) * kC);
            }
            for (int u = bx; u < 256; u += G) {
                const int h = u & 3, qb = u >> 2; const int r0 = 4 * qb, nlo = min(max(r0 - 4, 0), 244);
                att::attn_na(Z + (size_t)qb * 256 * ZLD + 1536 + h * 128, Z + 2048 + h * 128, Z + 2560 + h * 128, YS + (size_t)qb * 256 * YLD + 1024 + h * 128,
                             ZLD, ZLD, YLD, (char*)lds_raw, nlo, r0, INP(I_RPB) + (size_t)(l * 4 + h) * 465, qkb_n);
            }
            PROBE_END(); } SEAM(pb + 2);
        }
        if (IN(pb + 3)) { PROBE_REP(6) { LAUNDER_TID();
            pg8::ProbOut P{(const char*)YS, (const char*)(wl + WL_OUT), YLD, YLD, 128L * YLD * 2, 128L * YLD * 2, 256L * YLD * 2, 256L * YLD * 2};
            pg8::StaticOrder S; S.init(nPan, 32, G, bx); pg8::EpiPlain1 E{PB, PLD, 1.0f, 0, 0};
            pg8::gemm_phase(lds, P, S, E);
            PROBE_END(); } SEAM(pb + 3);
        }
        if (IN(pb + 4)) { PROBE_REP(7) { LAUNDER_TID();
            pg8::ProbPlain P{(const char*)XN, (const char*)(wl + WL_GATE), 2048, 2048, 128L * 2048 * 2, 128L * 2048 * 2, 256L * 2048 * 2, 256L * 2048 * 2, 32};
            if (!lastl) {
                const float* bg = INP(I_BGATE) + (size_t)l * 8192; const bf16_t* gc = (const bf16_t*)(ws + WS_GC);
                for (int i = bx * (NWAVES * 64) + tid; i < 256 * 256; i += G * NWAVES * 64) { const int row = i >> 8, d0 = (i & 255) * 8; float s[8];
#pragma unroll
                    for (int e = 0; e < 8; ++e) s[e] = 0.f;
#pragma unroll
                    for (int b = 0; b < 4; ++b) { const u32x4 gw4 = *(const u32x4*)(gc + (size_t)row * 8192 + rowmap(2, b * 2048 + d0)), pw4 = *(const u32x4*)(PB + (size_t)(SEQ + row) * PLD + b * 2048 + d0);
#pragma unroll
                        for (int e = 0; e < 8; ++e) { const float x = ((e & 1) ? bf_hi(gw4[e >> 1]) : bf_lo(gw4[e >> 1])) + GATE_PRESCALE * bg[b * 2048 + d0 + e], pv = (e & 1) ? bf_hi(pw4[e >> 1]) : bf_lo(pw4[e >> 1]);
                            s[e] += __builtin_amdgcn_rcpf(1.0f + __builtin_amdgcn_exp2f(x)) * pv; } }
                    u32x4 o; o.x = cvt_pk_bf16(s[0], s[1]); o.y = cvt_pk_bf16(s[2], s[3]); o.z = cvt_pk_bf16(s[4], s[5]); o.w = cvt_pk_bf16(s[6], s[7]);
                    *(u32x4*)(MG + (size_t)(SEQ + row) * D + d0) = o; }
            }
            pg8::StaticOrder S; S.init(64, 32, G, bx); pg8::EpiGate E{PB, INP(I_BGATE) + (size_t)l * 8192, MG};
            pg8::gemm_phase(lds, P, S, E);
            PROBE_END(); } SEAM(pb + 4);
        }
        if (IN(pb + 5)) { PROBE_REP(8) { LAUNDER_TID();
            pg8::ProbPlain P{(const char*)MG, (const char*)(wl + WL_O), 2048, 2048, 128L * 2048 * 2, 128L * 2048 * 2, 256L * 2048 * 2, 256L * 2048 * 2, 32};
            { pg8::StaticOrder S; S.init(64, 8, G, bx); pg8::EpiResid E{l == 0 ? (const void*)INP(I_X) : (const void*)HB, HB, modL + 2 * D, l != 0, 1};
              pg8::gemm_phase(lds, P, S, E); }
            if (!lastl) {
              pg8::ProbPlain Pc{(const char*)(MG + (size_t)SEQ * D), (const char*)(wl + WL_O), 2048, 2048, 128L * 2048 * 2, 128L * 2048 * 2, 256L * 2, 256L * 2048 * 2, 4, 256L * 2};
              pg8::StaticOrder S; S.init(8, 8, G, bx); pg8::EpiF32 E{(float*)(ws + WS_PWO), D, (size_t)256 * D};
              pg8::gemm_phase(lds, Pc, S, E); }
            PROBE_END(); } SEAM(pb + 5);
        }
        if (IN(pb + 6)) { LAUNDER_TID();
            const int mypm = 8 * (bxr & 7) + ((bxr >> 3) & 7), myq = (bxr >> 6) & 3;
            { const bool hv = !lastl; norm_lat_rows(HB, 1, 256 * mypm + 64 * myq + (hv ? 9 : 8) * wave, hv ? (wave < 7 ? 9 : 1) : 8, INP(I_NORM2) + l * D, modL, 3 * D, XN, lane); }
            if (!lastl && wave == 7 && bxr < CTXL) norm_ctx_row(bx, hCx, (const float*)(ws + WS_PWO), 8, modC + 2 * D, HC, INP(I_NORM2) + l * D, modC, 3 * D, XN, lane);
            team_arrive(tcnt + (1 * 65 + mypm) * 64, tcnt + (1 * 65 + 64) * 64);
            team_wait(tcnt + (1 * 65 + mypm) * 64, 4u, ttmo);
            pg8::ProbPlain P{(const char*)XN, (const char*)(wl + WL_UP), 2048, 2048, 128L * 2048 * 2, 128L * 2048 * 2, 256L * 2048 * 2, 256L * 2048 * 2, 32};
            { pg8::StaticOrder S; S.init(64, 44, G, bx); pg8::EpiUpConv E{ACT, (float*)(ws + WS_SB), INP(I_FCW) + (size_t)l * 3 * ULD, (LAS float*)(lds + HALO_OFF)};
              pg8::gemm_phase(lds, P, S, E); }
            if (!lastl) {
              team_wait(tcnt + (1 * 65 + 64) * 64, (unsigned)G, ttmo);
              pg8::ProbPlain Pc{(const char*)(XN + (size_t)SEQ * D), (const char*)(wl + WL_UP), 2048, 2048, 128L * 2048 * 2, 128L * 2048 * 2, 512L * 2, 256L * 2048 * 2, 8, 512L * 2};
              pg8::StaticOrder S; S.init(4, 44, G, bx); pg8::EpiF32 E{(float*)(ws + WS_PUP), ULD, (size_t)256 * ULD};
              pg8::gemm_phase(lds, Pc, S, E); }
            SEAM(pb + 6);
        }
        if (IN(pb + 7)) { LAUNDER_TID();
            const int mypm = 8 * (bxr & 7) + ((bxr >> 3) & 7), myq = (bxr >> 6) & 3;
            const float* fw = INP(I_FCW) + (size_t)l * 3 * ULD;
            {
              const float* sb = (const float*)(ws + WS_SB);
              for (int i = tid; i < 2 * 704; i += NWAVES * 64) { const int which = i / 704, cp = (i % 704) * 2 + myq * 1408;
                  const int pc = 256 * (cp >> 7) + (cp & 127);
                  const float* r0 = which == 0 ? (mypm > 0 ? sb + ((size_t)(mypm - 1) * 4 + 3) * ULD : nullptr) : sb + ((size_t)mypm * 4 + 2) * ULD;
                  const float* r1 = sb + ((size_t)mypm * 4 + (which == 0 ? 0 : 3)) * ULD;
                  const float* r2 = which == 0 ? sb + ((size_t)mypm * 4 + 1) * ULD : (mypm < 63 ? sb + ((size_t)(mypm + 1) * 4 + 0) * ULD : nullptr);
                  float o[2];
#pragma unroll
                  for (int e = 0; e < 2; ++e) { const float a0 = r0 ? r0[pc + e] : 0.f, a1 = r1[pc + e], a2 = r2 ? r2[pc + e] : 0.f, g0 = r0 ? r0[pc + 128 + e] : 0.f, g1 = r1[pc + 128 + e], g2 = r2 ? r2[pc + 128 + e] : 0.f;
                      const float ua = a0 * fw[cp + e] + a1 * fw[ULD + cp + e] + a2 * fw[2 * ULD + cp + e], ug = g0 * fw[FF + cp + e] + g1 * fw[ULD + FF + cp + e] + g2 * fw[2 * ULD + FF + cp + e];
                      o[e] = ua * __builtin_amdgcn_rcpf(1.0f + __builtin_amdgcn_exp2f(-1.4426950408889634f * ua)) * ug; }
                  __hip_atomic_store((unsigned*)(ACT + (size_t)(256 * mypm + (which == 0 ? 0 : 255)) * FF + cp), cvt_pk_bf16(o[0], o[1]), __ATOMIC_RELAXED, __HIP_MEMORY_SCOPE_AGENT); } }
            if (!lastl)
                for (int it = gw; it < 11 * 64; it += NGW) { const int cc = it % 11, rb = it / 11, t0 = rb * 4;
                    ffn_conv_rows<true, 4>(nullptr, (const float*)(ws + WS_PUP), fw, ACT + (size_t)SEQ * FF, t0, cc * 512 + 8 * lane, t0 != 0, t0 + 4 != CTXL); }
            team_arrive(TCNT(ST_CONV, mypm), TCNT(ST_CONV, 64));
            team_wait(TCNT(ST_CONV, mypm), 4u, ttmo);
            pg8::ProbPlain P{(const char*)ACT, (const char*)(wl + WL_DOWN), FF, FF, 128L * FF * 2, 128L * FF * 2, 256L * FF * 2, 256L * FF * 2, 88};
            { pg8::StaticOrder S; S.init(64, 8, G, bx); pg8::EpiResid E{HB, lastl ? (void*)OUTP : (void*)HB, modL + 5 * D, 1, lastl ? 0 : 1};
              pg8::gemm_phase(lds, P, S, E); }
            if (!lastl) {
              team_wait(TCNT(ST_CONV, 64), (unsigned)G, ttmo);
              pg8::ProbPlain Pc{(const char*)(ACT + (size_t)SEQ * FF), (const char*)(wl + WL_DOWN), FF, FF, 128L * FF * 2, 128L * FF * 2, 512L * 2, 256L * FF * 2, 8, 512L * 2};
              pg8::StaticOrder S; S.init(11, 8, G, bx); pg8::EpiF32 E{(float*)(ws + WS_PDN), D, (size_t)256 * D};
              pg8::gemm_phase(lds, Pc, S, E); }
            SEAM(pb + 7);
        }
    }
#undef XN
#undef Z
#undef XT
#undef YT
#undef YS
#undef PB
#undef HB
#undef MG
#undef ACT
#undef XTC
#undef HC
#undef MOD
#undef ADAP
#undef D1
#undef DCT
#undef DCTX
#undef TW
#undef RT
#undef CT
#undef OUTP
#undef wl
#undef modL
#undef modC
#undef hL
#undef hCx
#undef TCNT
#undef IN
#undef SEAM
#undef GRID_BAR
#undef INP
}

constexpr int N_PHASES = 2 + 8 * DEPTH;

extern "C" void kernel_launch(void* const* d_in, const int* in_sizes, int n_in, void* d_out, int out_size, void* d_ws, size_t ws_size, hipStream_t stream) {
    static int grid = 0;
    if (grid == 0) {
        if (n_in != 25 || out_size != SEQ * D || ws_size < WS_END) { fprintf(stderr, "kernel_launch: unexpected shapes (n_in %d out %d ws %zu need %zu)\n", n_in, out_size, ws_size, (size_t)WS_END); grid = -1; return; }
        int dev = 0, cus = 0;
        if (hipGetDevice(&dev) != hipSuccess || hipDeviceGetAttribute(&cus, hipDeviceAttributeMultiprocessorCount, dev) != hipSuccess) { grid = -1; return; }
        if (hipFuncSetAttribute((const void*)fwd, hipFuncAttributeMaxDynamicSharedMemorySize, LDS_BYTES) != hipSuccess) { fprintf(stderr, "kernel_launch: hipFuncSetAttribute failed\n"); grid = -1; return; }
        int per_cu = 0;
        if (hipOccupancyMaxActiveBlocksPerMultiprocessor(&per_cu, (const void*)fwd, NWAVES * 64, LDS_BYTES) != hipSuccess || per_cu < 1) fprintf(stderr, "kernel_launch: occupancy query reports %d\n", per_cu);
        (void)hipGetLastError();
        grid = cus;
    }
    if (grid < 0) return;
    if (hipMemsetAsync((char*)d_ws + WS_CTL, 0, CTL_ZERO_BYTES, stream) != hipSuccess) return;
    Args a{};
    for (int i = 0; i < 25; ++i) a.in[i] = (const float*)d_in[i];
    a.out = (float*)d_out; a.ws = (unsigned char*)d_ws;
#if MK_PER_PHASE
    for (int p = 0; p < N_PHASES; ++p) { a.ph_lo = p; a.ph_hi = p + 1; hipLaunchKernelGGL(fwd, dim3(grid), dim3(NWAVES * 64), LDS_BYTES, stream, a); }
#else
    a.ph_lo = 0; a.ph_hi = N_PHASES; hipLaunchKernelGGL(fwd, dim3(grid), dim3(NWAVES * 64), LDS_BYTES, stream, a);
#endif
    const hipError_t le = hipPeekAtLastError();
    if (le != hipSuccess) fprintf(stderr, "kernel_launch: launch failed: %s\n", hipGetErrorName(le));
}
```

```cpp
#include <hip/hip_runtime.h>
#include <cstdio>
#include <cstdint>

#ifndef PROBE_DUP
#define PROBE_DUP (-1)
#endif
#define PROBE_REP(i) for (int rep_ = 0; rep_ < ((PROBE_DUP == (i)) ? 2 : 1); ++rep_)
#define PROBE_END() do { if (PROBE_DUP >= 0) __syncthreads(); } while (0)
#ifndef MK_PER_PHASE
#define MK_PER_PHASE 0
#endif

#define LAS __attribute__((address_space(3)))
#define GAS __attribute__((address_space(1)))
typedef unsigned short bf16_t;
typedef short bf16x8 __attribute__((ext_vector_type(8)));
typedef short s16x4 __attribute__((ext_vector_type(4)));
typedef float f32x2 __attribute__((ext_vector_type(2)));
typedef float f32x4 __attribute__((ext_vector_type(4)));
typedef float f32x16 __attribute__((ext_vector_type(16)));
typedef unsigned u32x2 __attribute__((ext_vector_type(2)));
typedef unsigned u32x4 __attribute__((ext_vector_type(4)));

constexpr int D = 2048, SEQ = 16384, CTXL = 256, MT = SEQ + CTXL, DEPTH = 4;
constexpr int ZLD = 4608;
constexpr int YLD = 2560;
constexpr int PLD = 8192;
constexpr int ULD = 11264, FF = 5632, NIN = 5120, NADA = 12288;
constexpr float EPS = 1e-6f;
constexpr float GATE_PRESCALE = -1.4426950408889634f;
constexpr float QK_PRESCALE = 0.088388347648318440f * 1.4426950408889634f;
constexpr int NWAVES = 8;

constexpr size_t MiB = 1u << 20;
constexpr size_t WS_CTL = 0, CTL_ZERO_BYTES = 1 * MiB;
constexpr size_t WS_D1 = 1 * MiB;
constexpr size_t WS_DCT = WS_D1 + 128 * 1024;
constexpr size_t WS_DCTX = WS_DCT + 1 * MiB;
constexpr size_t WS_TW = WS_DCTX + 256 * 1024;
constexpr size_t WS_RT = WS_TW + 128 * 1024;
constexpr size_t WS_CT = WS_RT + 64 * 1024;
constexpr size_t WS_MOD = 3 * MiB;
constexpr size_t WS_ADAP = 4 * MiB;
constexpr size_t WS_HC = 16 * MiB;
constexpr size_t WS_XTC = 18 * MiB;
constexpr size_t WS_W = 20 * MiB;
constexpr size_t WL_IN = 0;
constexpr size_t WL_FT = WL_IN + (size_t)4608 * 2048 * 2;
constexpr size_t WL_INF = WL_IN + (size_t)5632 * 2048 * 2;
constexpr size_t WL_GATE = WL_INF + (size_t)2048 * 512 * 2;
constexpr size_t WL_O = WL_GATE + (size_t)8192 * 2048 * 2;
constexpr size_t WL_UP = WL_O + (size_t)2048 * 2048 * 2;
constexpr size_t WL_DOWN = WL_UP + (size_t)11264 * 2048 * 2;
constexpr size_t WL_OUT = WL_DOWN + (size_t)2048 * 5632 * 2;
constexpr size_t WL_STRIDE = WL_OUT + (size_t)2048 * 2560 * 2;
constexpr size_t WS_XN = WS_W + 4 * WL_STRIDE;
constexpr size_t WS_Z = WS_XN + (size_t)MT * D * 2;
constexpr size_t WS_XT = WS_Z + (size_t)MT * ZLD * 2;
constexpr size_t WS_YT = WS_XT + (size_t)65536 * 256 * 2;
constexpr size_t WS_YS = WS_YT + (size_t)65536 * 256 * 2;
constexpr size_t WS_P = WS_YS + (size_t)MT * YLD * 2;
constexpr size_t WS_ACT = WS_Z;
constexpr size_t WS_MG = WS_P + (size_t)MT * PLD * 2;
constexpr size_t WS_HB = WS_MG + (size_t)MT * D * 2;
constexpr size_t WS_PWO = WS_HB + (size_t)SEQ * D * 2;
constexpr size_t WS_PDN = WS_PWO + (size_t)8 * 256 * 2048 * 4;
constexpr size_t WS_GC = WS_PDN + (size_t)11 * 256 * 2048 * 4;
constexpr size_t WS_PUP = WS_GC + (size_t)256 * 8192 * 2;
constexpr size_t WS_SB = WS_PUP + (size_t)4 * 256 * ULD * 4;
constexpr size_t WS_END = WS_SB + (size_t)64 * 4 * ULD * 4 + MiB;
static_assert(WS_ACT + (size_t)MT * FF * 2 <= WS_YS, "ACT overlay");
static_assert(WL_STRIDE % 256 == 0 && WS_XN % 256 == 0, "align");
constexpr int CW_BAR = 4096;
constexpr int CW_TEAM = 8192, NSTEP = 3;
enum { ST_NORM1 = 0, ST_NORM2 = 1, ST_CONV = 2 };
static_assert((CW_TEAM + 4 * NSTEP * 65 * 64) * 4 <= (int)CTL_ZERO_BYTES, "counters inside the memset region");

constexpr int RING_BYTES = 131072, LDSCTL_OFF = RING_BYTES, MISC_OFF = LDSCTL_OFF + 320, PTAB_OFF = LDSCTL_OFF + 512, HALO_OFF = LDSCTL_OFF + 2048  , LDS_BYTES = 147456;

#define LDS_WAIT() asm volatile("s_waitcnt lgkmcnt(0)" ::: "memory")
#define VM_WAIT() asm volatile("s_waitcnt vmcnt(0)" ::: "memory")
__device__ __forceinline__ unsigned cvt_pk_bf16(float lo, float hi) { unsigned r; asm("v_cvt_pk_bf16_f32 %0, %1, %2" : "=v"(r) : "v"(lo), "v"(hi)); return r; }
__device__ __forceinline__ float bf_lo(unsigned w) { return __uint_as_float(w << 16); }
__device__ __forceinline__ float bf_hi(unsigned w) { return __uint_as_float(w & 0xffff0000u); }
template <class T> __device__ __forceinline__ void st_off(void* base, unsigned off, T v) { *(GAS T*)((GAS char*)base + off) = v; }
template <class T> __device__ __forceinline__ T ld_off(const void* base, unsigned off) { return *(const GAS T*)((const GAS char*)base + off); }
__device__ __forceinline__ float shfl_xor_l(float v, int lane, int o) { return __int_as_float(__builtin_amdgcn_ds_bpermute((lane ^ o) << 2, __float_as_int(v))); }
__device__ __forceinline__ float wave_sum(float v, int lane) {
#pragma unroll
    for (int o = 1; o < 64; o <<= 1) v += shfl_xor_l(v, lane, o);
    return v;
}

#define XB_TMO      128
#define XB_XCNT(j)  (256  + 64 * (j))
#define XB_XSUB(j)  (1280 + 64 * (j))
#define XB_XGEN(j)  (2304 + 64 * (j))
#define XB_TOP      3328
#define XB_TOPGEN   3392
#define XCD_BAR_WORDS 3456
#define XB_SPIN_CAP (1u << 18)
__device__ __forceinline__ unsigned xb_ld(unsigned* p)              { return __hip_atomic_load(p, __ATOMIC_RELAXED, __HIP_MEMORY_SCOPE_AGENT); }
__device__ __forceinline__ unsigned xb_add(unsigned* p, unsigned v) { return __hip_atomic_fetch_add(p, v, __ATOMIC_RELAXED, __HIP_MEMORY_SCOPE_AGENT); }
__device__ __forceinline__ unsigned xb_xcc_id() { return (unsigned)__builtin_amdgcn_s_getreg((3 << 11) | 20) & 0xFu; }
#define XB_SPIN(cond, bar) do { unsigned _sp = 0; while (cond) { __builtin_amdgcn_s_sleep(1); \
    if ((++_sp & 255u) == 0u) { if (xb_ld(&(bar)[XB_TMO])) break; if (_sp > XB_SPIN_CAP) { atomicAdd(&(bar)[XB_TMO], 1u); break; } } } } while (0)
struct XcdBarrier { unsigned* bar; unsigned x; volatile LAS unsigned* st; };
__device__ __forceinline__ XcdBarrier xcd_barrier_post(unsigned* bar, volatile LAS unsigned* st) {
    XcdBarrier b; b.bar = bar; b.x = xb_xcc_id(); b.st = st;
    if (threadIdx.x == 0) (void)xb_add(&bar[XB_XCNT(b.x)], 1u);
    return b;
}
__device__ __forceinline__ void xcd_barrier_complete(unsigned* bar, unsigned x, unsigned& nloc, unsigned& nx) {
    const unsigned G = gridDim.x * gridDim.y * gridDim.z;
    unsigned sum, cnt, mine, sp = 0u;
    for (;;) {
        sum = 0u; cnt = 0u; mine = 0u;
#pragma unroll
        for (unsigned j = 0; j < 16; ++j) { const unsigned c = xb_ld(&bar[XB_XCNT(j)]); sum += c; cnt += (c > 0u) ? 1u : 0u; mine = (j == x) ? c : mine; }
        if (sum == G) break;
        __builtin_amdgcn_s_sleep(1);
        if ((++sp & 255u) == 0u) { if (xb_ld(&bar[XB_TMO])) break; if (sp > XB_SPIN_CAP) { atomicAdd(&bar[XB_TMO], 1u); break; } }
    }
    nloc = mine > 0u ? mine : 1u; nx = cnt > 0u ? cnt : 1u;
}
__device__ __forceinline__ void xcd_barrier(const XcdBarrier& b) {
    asm volatile("s_waitcnt vmcnt(0)" ::: "memory");
    __syncthreads();
    if (threadIdx.x == 0) {
        unsigned* bar = b.bar;
        __builtin_amdgcn_s_waitcnt(0);
        unsigned nloc = b.st[0], nx = b.st[1];
        if (nloc == 0u) { xcd_barrier_complete(bar, b.x, nloc, nx); b.st[0] = nloc; b.st[1] = nx; }
        const unsigned old = xb_add(&bar[XB_XSUB(b.x)], 1u);
        const unsigned gen = old / nloc;
        if (old + 1u == (gen + 1u) * nloc) {
            __builtin_amdgcn_fence(__ATOMIC_RELEASE, "agent");
            asm volatile("s_waitcnt vmcnt(0)" ::: "memory");
            const unsigned og = xb_add(&bar[XB_TOP], 1u);
            const unsigned tg = og / nx;
            if (og + 1u == (tg + 1u) * nx) xb_add(&bar[XB_TOPGEN], 1u);
            else XB_SPIN(xb_ld(&bar[XB_TOPGEN]) == tg, bar);
            __builtin_amdgcn_fence(__ATOMIC_ACQUIRE, "agent");
            xb_add(&bar[XB_XGEN(b.x)], 1u);
            asm volatile("s_waitcnt vmcnt(0)" ::: "memory");
        } else {
            XB_SPIN(xb_ld(&bar[XB_XGEN(b.x)]) == gen, bar);
            __builtin_amdgcn_fence(__ATOMIC_ACQUIRE, "agent");
            asm volatile("s_waitcnt vmcnt(0)" ::: "memory");
        }
    }
    __syncthreads();
}

__device__ __forceinline__ void team_arrive(unsigned* w1, unsigned* w2) {
    asm volatile("s_waitcnt vmcnt(0)" ::: "memory"); __syncthreads();
    if (threadIdx.x == 0) { (void)xb_add(w1, 1u); (void)xb_add(w2, 1u); }
}
__device__ __forceinline__ void team_wait(unsigned* w, unsigned need, unsigned* tmo) {
    if (threadIdx.x == 0) { unsigned sp = 0u;
        while (xb_ld(w) < need) { __builtin_amdgcn_s_sleep(1); if ((++sp & 255u) == 0u) { if (xb_ld(tmo)) break; if (sp > XB_SPIN_CAP) { atomicAdd(tmo, 1u); break; } } }
        __builtin_amdgcn_fence(__ATOMIC_ACQUIRE, "agent"); asm volatile("s_waitcnt vmcnt(0)" ::: "memory"); }
    __syncthreads();
}

namespace pg8 {
constexpr int BM = 256, BK = 64, HALF = 128, HTB = HALF * BK * 2, STAGE_BYTES = 8 * HTB, NXCD = 8, WGM = 8;
__host__ __device__ __forceinline__ int lds_byte(int r, int c) { const int st = (r >> 4) * 2 + (c >> 5), rr = r & 15, cc = c & 31, ob = rr * 64 + cc * 2; return st * 1024 + (ob ^ (((ob >> 9) & 1) << 5)); }
__host__ __device__ __forceinline__ void stage_rc(int b, int& R, int& C) { const int st = b / 1024, sb = b % 1024, swz = sb ^ (((sb >> 9) & 1) << 5); R = (st >> 1) * 16 + swz / 64; C = (st & 1) * 32 + (swz % 64) / 2; }
__host__ __device__ __forceinline__ int perm32(int rho) { const int n = rho >> 4, i = rho & 15; return 8 * (i >> 2) + 4 * n + (i & 3); }
struct Unit { int pm, pn; };
struct StaticOrder {
    int nM, nN, nwg, G, c;
    __device__ __forceinline__ void init(int nM_, int nN_, int G_, int c_) { nM = nM_; nN = nN_; nwg = nM * nN; G = G_; c = c_; }
    __device__ __forceinline__ bool next(int i, Unit& u) const {
        const long L = (long)i * G + c; if (L >= nwg) return false;
        int wgid = (int)L; { const int q = nwg / NXCD, r = nwg % NXCD, xcd = wgid % NXCD, off = wgid / NXCD; wgid = (xcd < r ? xcd * (q + 1) : r * (q + 1) + (xcd - r) * q) + off; }
        const int nig = WGM * nN, gid = wgid / nig, fm = gid * WGM, gsz = (nM - fm) < WGM ? (nM - fm) : WGM;
        u.pm = fm + ((wgid % nig) % gsz); u.pn = (wgid % nig) / gsz; return true;
    }
};
struct ProbPlain {
    const char* A; const char* B; int lda, ldb; long hA, hB, tA, tB; int nt; long kB;
    __device__ __forceinline__ void locate(const Unit& u, const char*& cA, const char*& cB, int& n) const { cA = A + (long)u.pm * tA; cB = B + (long)u.pn * tB + (long)u.pm * kB; n = nt; }
};
struct ProbOut {
    const char* A; const char* B; int lda, ldb; long hA, hB, tA, tB;
    __device__ __forceinline__ void locate(const Unit& u, const char*& cA, const char*& cB, int& n) const {
        const int b = u.pn >> 3; const long koff = (long)b * 512 * 2;
        cA = A + (long)u.pm * tA + koff; cB = B + (long)(u.pn & 7) * tB + koff; n = (b == 3) ? 16 : 8; }
};
struct ProbFold {
    const char* A; const char* B; int lda, ldb; long hA, hB, tA, tB; long lB;
    __device__ __forceinline__ void locate(const Unit& u, const char*& cA, const char*& cB, int& n) const { cA = A + (long)(u.pm & 3) * tA; cB = B + (long)(u.pm >> 2) * lB + (long)u.pn * tB; n = 8; }
};

template <bool SCALED = true>
struct EpiPlainT {
    static constexpr bool APERM = false; static constexpr bool PERM = true;
    bf16_t* O; int ldc; float sc; int pm_mod; size_t gstride;
    __device__ __forceinline__ void operator()(const f32x4 (&acc)[2][2][4][2], const Unit& u) const {
        int t_ = threadIdx.x; asm volatile("" : "+v"(t_)); const int wid_ = __builtin_amdgcn_readfirstlane(t_ >> 6), wr = wid_ >> 2, wc = wid_ & 3, fr = t_ & 15, fq = (t_ >> 4) & 3;
        int pm = u.pm; bf16_t* base = O; if (pm_mod) { base += (size_t)(pm / pm_mod) * gstride; pm = pm % pm_mod; }
        base += (size_t)pm * BM * ldc + u.pn * BM;
        const unsigned off0 = (unsigned)((wr * 64 + fr) * ldc + wc * 32 + 8 * fq) * 2u;
#pragma unroll
        for (int ai = 0; ai < 2; ++ai)
#pragma unroll
            for (int m = 0; m < 4; ++m) { const unsigned off = off0 + (unsigned)((ai * HALF + m * 16) * ldc) * 2u;
#pragma unroll
                for (int bj = 0; bj < 2; ++bj) { f32x4 v0 = acc[ai][bj][m][0], v1 = acc[ai][bj][m][1]; if constexpr (SCALED) { v0 *= sc; v1 *= sc; }
                    u32x4 w; w.x = cvt_pk_bf16(v0[0], v0[1]); w.y = cvt_pk_bf16(v0[2], v0[3]); w.z = cvt_pk_bf16(v1[0], v1[1]); w.w = cvt_pk_bf16(v1[2], v1[3]);
                    st_off(base, off + bj * HALF * 2, w); } }
    }
};
using EpiPlain = EpiPlainT<true>; using EpiPlain1 = EpiPlainT<false>;
struct EpiZ {
    static constexpr bool APERM = false; static constexpr bool PERM = true;
    bf16_t* O; const float* naq; const float* nak; const float* gqg; const float* gkg; const f32x2* RT; const f32x2* CT; LAS float* SL; int ctx;
    __device__ __forceinline__ void operator()(const f32x4 (&acc)[2][2][4][2], const Unit& u) const {
        int t_ = threadIdx.x; asm volatile("" : "+v"(t_)); const int wid_ = __builtin_amdgcn_readfirstlane(t_ >> 6), wr = wid_ >> 2, wc = wid_ & 3, fr = t_ & 15, fq = (t_ >> 4) & 3, ln = t_ & 63;
        bf16_t* base = O + (size_t)u.pm * BM * ZLD + u.pn * BM;
        const unsigned off0 = (unsigned)((wr * 64 + fr) * ZLD + wc * 32 + 8 * fq) * 2u;
        const int pn = u.pn; const int kind = (pn >= 6 && pn < 8) ? 1 : (pn >= 8 && pn < 10) ? 2 : (pn >= 12 && pn < 16) ? 3 : (pn == 16) ? 4 : 0;
        if (kind == 0) {
#pragma unroll
            for (int ai = 0; ai < 2; ++ai)
#pragma unroll
                for (int m = 0; m < 4; ++m) { const unsigned off = off0 + (unsigned)((ai * HALF + m * 16) * ZLD) * 2u;
#pragma unroll
                    for (int bj = 0; bj < 2; ++bj) { const f32x4 v0 = acc[ai][bj][m][0], v1 = acc[ai][bj][m][1];
                        u32x4 w; w.x = cvt_pk_bf16(v0[0], v0[1]); w.y = cvt_pk_bf16(v0[2], v0[3]); w.z = cvt_pk_bf16(v1[0], v1[1]); w.w = cvt_pk_bf16(v1[2], v1[3]);
                        st_off(base, off + bj * HALF * 2, w); } }
        }
        if (kind != 0) {
#pragma unroll
            for (int ai = 0; ai < 2; ++ai)
#pragma unroll
                for (int m = 0; m < 4; ++m)
#pragma unroll
                    for (int bj = 0; bj < 2; ++bj) { const f32x4 v0 = acc[ai][bj][m][0], v1 = acc[ai][bj][m][1];
                        float ss = ((v0[0] * v0[0] + v0[1] * v0[1]) + (v0[2] * v0[2] + v0[3] * v0[3])) + ((v1[0] * v1[0] + v1[1] * v1[1]) + (v1[2] * v1[2] + v1[3] * v1[3]));
                        ss += __int_as_float(__builtin_amdgcn_ds_bpermute((ln ^ 16) << 2, __float_as_int(ss))); ss += __int_as_float(__builtin_amdgcn_ds_bpermute((ln ^ 32) << 2, __float_as_int(ss)));
                        if (fq == 0) SL[((ai * HALF + wr * 64 + m * 16 + fr) * 2 + bj) * 4 + wc] = ss; }
        }
        asm volatile("s_waitcnt lgkmcnt(0)" ::: "memory"); __builtin_amdgcn_s_barrier(); asm volatile("" ::: "memory");
        if (kind != 0) {
            const float* gn = kind == 1 ? naq : kind == 2 ? nak : kind == 3 ? gqg : gkg; const bool rope = (kind >= 3) && !ctx;
            const float qs = (kind & 1) ? QK_PRESCALE : 1.0f;
            const int d0 = (kind >= 3) ? 16 * wc + 4 * fq : 32 * wc + 8 * fq, dstep = (kind >= 3) ? 64 : 4;
            const f32x4 g0 = *(const f32x4*)(gn + d0), g1 = *(const f32x4*)(gn + d0 + dstep);
#pragma unroll
            for (int ai = 0; ai < 2; ++ai)
#pragma unroll
                for (int m = 0; m < 4; ++m) { const int rl = ai * HALF + wr * 64 + m * 16 + fr; const unsigned off = off0 + (unsigned)((ai * HALF + m * 16) * ZLD) * 2u;
                    const int tok = u.pm * BM + rl;
                    f32x2 cs[4];
                    if (rope) { const f32x2* tb = (wc < 2) ? RT + ((tok >> 6) & 255) * 32 + 16 * wc + 4 * fq : CT + (tok & 63) * 32 + 16 * (wc - 2) + 4 * fq;
#pragma unroll
                        for (int j = 0; j < 4; ++j) cs[j] = tb[j]; }
#pragma unroll
                    for (int bj = 0; bj < 2; ++bj) { const f32x4 p = *(const LAS f32x4*)(SL + (rl * 2 + bj) * 4);
                        const float rstd = qs / sqrtf(((p[0] + p[1]) + (p[2] + p[3])) * (1.0f / 128.0f) + EPS);
                        f32x4 y0 = acc[ai][bj][m][0] * rstd * g0, y1 = acc[ai][bj][m][1] * rstd * g1;
                        if (rope) {
#pragma unroll
                            for (int j = 0; j < 4; ++j) { const float a = y0[j] * cs[j].x - y1[j] * cs[j].y, b = y0[j] * cs[j].y + y1[j] * cs[j].x; y0[j] = a; y1[j] = b; } }
                        u32x4 w; w.x = cvt_pk_bf16(y0[0], y0[1]); w.y = cvt_pk_bf16(y0[2], y0[3]); w.z = cvt_pk_bf16(y1[0], y1[1]); w.w = cvt_pk_bf16(y1[2], y1[3]);
                        st_off(base, off + bj * HALF * 2, w); } }
        }
        asm volatile("s_waitcnt lgkmcnt(0)" ::: "memory");
    }
};
struct EpiF0 {
    static constexpr bool APERM = false; static constexpr bool PERM = true;
    bf16_t* XT;
    __device__ __forceinline__ void operator()(const f32x4 (&acc)[2][2][4][2], const Unit& u) const {
        int t_ = threadIdx.x; asm volatile("" : "+v"(t_)); const int wid_ = __builtin_amdgcn_readfirstlane(t_ >> 6), wr = wid_ >> 2, wc = wid_ & 3, fr = t_ & 15, fq = (t_ >> 4) & 3;
        bf16_t* xbase = XT + ((size_t)(u.pm * 128) * 128 + 2 * u.pn) * 256;
        const unsigned tA0 = (unsigned)(wc * 32 + 8 * fq);
#pragma unroll
        for (int ai = 0; ai < 2; ++ai)
#pragma unroll
            for (int m = 0; m < 4; ++m) { const unsigned cp = (unsigned)(wr * 64 + m * 16 + fr);
#pragma unroll
                for (int bj = 0; bj < 2; ++bj) { const f32x4 v0 = acc[ai][bj][m][0], v1 = acc[ai][bj][m][1];
                    u32x4 w; w.x = cvt_pk_bf16(v0[0], v0[1]); w.y = cvt_pk_bf16(v0[2], v0[3]); w.z = cvt_pk_bf16(v1[0], v1[1]); w.w = cvt_pk_bf16(v1[2], v1[3]);
                    st_off(xbase, (((cp * 128u + bj) * 2u + ai) * 128u + tA0) * 2u, w); } }
    }
};
struct EpiF0c {
    static constexpr bool APERM = false; static constexpr bool PERM = true;
    bf16_t* XTc;
    __device__ __forceinline__ void operator()(const f32x4 (&acc)[2][2][4][2], const Unit& u) const {
        int t_ = threadIdx.x; asm volatile("" : "+v"(t_)); const int wid_ = __builtin_amdgcn_readfirstlane(t_ >> 6), wr = wid_ >> 2, wc = wid_ & 3, fr = t_ & 15, fq = (t_ >> 4) & 3;
        bf16_t* xbase = XTc + (size_t)(u.pm * 128) * 512;
#pragma unroll
        for (int ai = 0; ai < 2; ++ai)
#pragma unroll
            for (int m = 0; m < 4; ++m) { const unsigned cp = (unsigned)(wr * 64 + m * 16 + fr);
#pragma unroll
                for (int bj = 0; bj < 2; ++bj) { const unsigned t0 = (unsigned)(bj * 128 + wc * 32 + 8 * fq); const f32x4 v0 = acc[ai][bj][m][0], v1 = acc[ai][bj][m][1];
                    u32x4 w; w.x = cvt_pk_bf16(v0[0], v0[1]); w.y = cvt_pk_bf16(v0[2], v0[3]); w.z = cvt_pk_bf16(v1[0], v1[1]); w.w = cvt_pk_bf16(v1[2], v1[3]);
                    st_off(xbase, ((cp * 2u + ai) * 256u + t0) * 2u, w); } }
    }
};
struct EpiF1 {
    static constexpr bool APERM = false; static constexpr bool PERM = false;
    bf16_t* YT; const f32x2* TW; float sc;
    __device__ __forceinline__ void operator()(const f32x4 (&acc)[2][2][4][2], const Unit& u) const {
        int t_ = threadIdx.x; asm volatile("" : "+v"(t_)); const int wid_ = __builtin_amdgcn_readfirstlane(t_ >> 6), wr = wid_ >> 2, wc = wid_ & 3, fr = t_ & 15, fq = (t_ >> 4) & 3;
        const unsigned k1l = (unsigned)(wc * 32 + 4 * fq);
        f32x2 twc[8], twn[8];
        { const unsigned two = (k1l * 128u + (unsigned)(wr * 64 + fr)) * 8u;
#pragma unroll
          for (int q = 0; q < 8; ++q) twc[q] = ld_off<f32x2>(TW, two + (unsigned)(16 * (q >> 2) + (q & 3)) * 1024u); }
#pragma unroll
        for (int ai = 0; ai < 2; ++ai) { const int gc = 2 * u.pm + ai, g = gc >> 7, cp = gc & 127;
            bf16_t* ybase = YT + ((size_t)(g * 128) * 128 + cp) * 256;
#pragma unroll
            for (int m = 0; m < 4; ++m) { const unsigned tB = (unsigned)(wr * 64 + m * 16 + fr);
                const unsigned yo = k1l * 65536u + tB * 2u;
                if (ai * 4 + m < 7) { const unsigned tBn = (unsigned)(wr * 64 + ((m + 1) & 3) * 16 + fr), two = (k1l * 128u + tBn) * 8u;
#pragma unroll
                    for (int q = 0; q < 8; ++q) twn[q] = ld_off<f32x2>(TW, two + (unsigned)(16 * (q >> 2) + (q & 3)) * 1024u); }
                asm volatile("" ::: "memory");
#pragma unroll
                for (int n = 0; n < 2; ++n)
#pragma unroll
                    for (int j = 0; j < 4; ++j) { const unsigned kc = (unsigned)(16 * n + j);
                        const f32x2 tw = twc[4 * n + j]; const float yr = acc[ai][0][m][n][j], yi = acc[ai][1][m][n][j];
                        const float orr = (yr * tw.x + yi * tw.y) * sc, oi = (yi * tw.x - yr * tw.y) * sc;
                        const unsigned pk = cvt_pk_bf16(orr, oi);
                        st_off(ybase, yo + kc * 65536u, (bf16_t)(pk & 0xffffu)); st_off(ybase, yo + kc * 65536u + 256u, (bf16_t)(pk >> 16)); }
#pragma unroll
                for (int q = 0; q < 8; ++q) twc[q] = twn[q]; } }
    }
};
struct EpiF2 {
    static constexpr bool APERM = false; static constexpr bool PERM = false;
    bf16_t* YS; float sc;
    __device__ __forceinline__ void operator()(const f32x4 (&acc)[2][2][4][2], const Unit& u) const {
        int t_ = threadIdx.x; asm volatile("" : "+v"(t_)); const int wid_ = __builtin_amdgcn_readfirstlane(t_ >> 6), wr = wid_ >> 2, wc = wid_ & 3, fr = t_ & 15, fq = (t_ >> 4) & 3;
        const unsigned k2l = (unsigned)(wc * 32 + 4 * fq);
#pragma unroll
        for (int ai = 0; ai < 2; ++ai) { const int gk = 2 * u.pm + ai, g = gk >> 7, k1 = gk & 127;
            bf16_t* ybase = YS + (size_t)k1 * YLD + 512 + g * 128;
#pragma unroll
            for (int m = 0; m < 4; ++m) { const unsigned cp = (unsigned)(wr * 64 + m * 16 + fr);
                const unsigned yo = (k2l * 128u * YLD + cp) * 2u;
#pragma unroll
                for (int n = 0; n < 2; ++n)
#pragma unroll
                    for (int j = 0; j < 4; ++j) { const unsigned kc = (unsigned)(16 * n + j);
                        const unsigned pk = cvt_pk_bf16(acc[ai][0][m][n][j] * sc, 0.f);
                        st_off(ybase, yo + kc * (128u * YLD * 2u), (bf16_t)(pk & 0xffffu)); }
                asm volatile("" ::: "memory"); } }
    }
};
struct EpiF1s {
    static constexpr bool APERM = false; static constexpr bool PERM = true;
    bf16_t* YT; const f32x2* TW; float sc;
    __device__ __forceinline__ void operator()(const f32x4 (&acc)[2][2][4][2], const Unit& u) const {
        int t_ = threadIdx.x; asm volatile("" : "+v"(t_)); const int wid_ = __builtin_amdgcn_readfirstlane(t_ >> 6), wr = wid_ >> 2, wc = wid_ & 3, fr = t_ & 15, fq = (t_ >> 4) & 3;
        const unsigned tB0 = (unsigned)(wc * 32 + 8 * fq);
#pragma unroll
        for (int m = 0; m < 4; ++m) { const unsigned k1 = (unsigned)(wr * 64 + m * 16 + fr);
            f32x4 tw[4];
#pragma unroll
            for (int q = 0; q < 4; ++q) tw[q] = ld_off<f32x4>(TW, (k1 * 128u + tB0) * 8u + q * 16u);
#pragma unroll
            for (int bj = 0; bj < 2; ++bj) { const int gc = 2 * u.pn + bj, g = gc >> 7, cp = gc & 127;
                bf16_t* ybase = YT + ((size_t)(g * 128) * 128 + cp) * 256;
                float orr[8], oi[8];
#pragma unroll
                for (int n = 0; n < 2; ++n)
#pragma unroll
                    for (int j = 0; j < 4; ++j) { const int e = 4 * n + j; const float c = tw[e >> 1][2 * (e & 1)], s = tw[e >> 1][2 * (e & 1) + 1];
                        const float yr = acc[0][bj][m][n][j], yi = acc[1][bj][m][n][j];
                        orr[e] = (yr * c + yi * s) * sc; oi[e] = (yi * c - yr * s) * sc; }
                u32x4 wr_, wi_; wr_.x = cvt_pk_bf16(orr[0], orr[1]); wr_.y = cvt_pk_bf16(orr[2], orr[3]); wr_.z = cvt_pk_bf16(orr[4], orr[5]); wr_.w = cvt_pk_bf16(orr[6], orr[7]);
                wi_.x = cvt_pk_bf16(oi[0], oi[1]); wi_.y = cvt_pk_bf16(oi[2], oi[3]); wi_.z = cvt_pk_bf16(oi[4], oi[5]); wi_.w = cvt_pk_bf16(oi[6], oi[7]);
                const unsigned yo = k1 * 65536u + tB0 * 2u;
                st_off(ybase, yo, wr_); st_off(ybase, yo + 256u, wi_); }
            asm volatile("" ::: "memory"); }
    }
};
struct EpiF2s {
    static constexpr bool APERM = false; static constexpr bool PERM = true;
    bf16_t* YS; float sc;
    __device__ __forceinline__ void operator()(const f32x4 (&acc)[2][2][4][2], const Unit& u) const {
        int t_ = threadIdx.x; asm volatile("" : "+v"(t_)); const int wid_ = __builtin_amdgcn_readfirstlane(t_ >> 6), wr = wid_ >> 2, wc = wid_ & 3, fr = t_ & 15, fq = (t_ >> 4) & 3;
        const unsigned cp0 = (unsigned)(wc * 32 + 8 * fq);
#pragma unroll
        for (int bj = 0; bj < 2; ++bj) { const int gk = 2 * u.pn + bj, g = gk >> 7, k1 = gk & 127;
            bf16_t* ybase = YS + (size_t)k1 * YLD + 512 + g * 128;
#pragma unroll
            for (int m = 0; m < 4; ++m) { const unsigned k2 = (unsigned)(wr * 64 + m * 16 + fr);
                const f32x4 v0 = acc[0][bj][m][0] * sc, v1 = acc[0][bj][m][1] * sc;
                u32x4 w; w.x = cvt_pk_bf16(v0[0], v0[1]); w.y = cvt_pk_bf16(v0[2], v0[3]); w.z = cvt_pk_bf16(v1[0], v1[1]); w.w = cvt_pk_bf16(v1[2], v1[3]);
                st_off(ybase, (k2 * 128u * YLD + cp0) * 2u, w); }
            asm volatile("" ::: "memory"); }
    }
};
struct EpiF1cs {
    static constexpr bool APERM = false; static constexpr bool PERM = true;
    bf16_t* YS; float sc;
    __device__ __forceinline__ void operator()(const f32x4 (&acc)[2][2][4][2], const Unit& u) const {
        int t_ = threadIdx.x; asm volatile("" : "+v"(t_)); const int wid_ = __builtin_amdgcn_readfirstlane(t_ >> 6), wr = wid_ >> 2, wc = wid_ & 3, fr = t_ & 15, fq = (t_ >> 4) & 3;
        bf16_t* ybase = YS + (size_t)SEQ * YLD + 512 + u.pn * 256;
        const unsigned c0 = (unsigned)(wc * 32 + 8 * fq);
#pragma unroll
        for (int ai = 0; ai < 2; ++ai)
#pragma unroll
            for (int m = 0; m < 4; ++m) { const unsigned k = (unsigned)(ai * 128 + wr * 64 + m * 16 + fr);
#pragma unroll
                for (int bj = 0; bj < 2; ++bj) { const f32x4 v0 = acc[ai][bj][m][0] * sc, v1 = acc[ai][bj][m][1] * sc;
                    u32x4 w; w.x = cvt_pk_bf16(v0[0], v0[1]); w.y = cvt_pk_bf16(v0[2], v0[3]); w.z = cvt_pk_bf16(v1[0], v1[1]); w.w = cvt_pk_bf16(v1[2], v1[3]);
                    st_off(ybase, (k * YLD + bj * 128u + c0) * 2u, w); }
                asm volatile("" ::: "memory"); }
    }
};
struct EpiF1c {
    static constexpr bool APERM = false; static constexpr bool PERM = false;
    bf16_t* YS; float sc;
    __device__ __forceinline__ void operator()(const f32x4 (&acc)[2][2][4][2], const Unit& u) const {
        int t_ = threadIdx.x; asm volatile("" : "+v"(t_)); const int wid_ = __builtin_amdgcn_readfirstlane(t_ >> 6), wr = wid_ >> 2, wc = wid_ & 3, fr = t_ & 15, fq = (t_ >> 4) & 3;
        bf16_t* ybase = YS + (size_t)SEQ * YLD + 512 + u.pm * 256;
        const unsigned kl = (unsigned)(wc * 32 + 4 * fq);
#pragma unroll
        for (int ai = 0; ai < 2; ++ai)
#pragma unroll
            for (int m = 0; m < 4; ++m) { const unsigned row = (unsigned)(ai * 128 + wr * 64 + m * 16 + fr);
                const unsigned yo = (kl * YLD + row) * 2u;
#pragma unroll
                for (int bj = 0; bj < 2; ++bj)
#pragma unroll
                    for (int n = 0; n < 2; ++n)
#pragma unroll
                        for (int j = 0; j < 4; ++j) { const unsigned kc = (unsigned)(bj * 128 + 16 * n + j);
                            const unsigned pk = cvt_pk_bf16(acc[ai][bj][m][n][j] * sc, 0.f);
                            st_off(ybase, yo + kc * (YLD * 2u), (bf16_t)(pk & 0xffffu)); }
                asm volatile("" ::: "memory"); }
    }
};
struct EpiGate {
    static constexpr bool APERM = false; static constexpr bool PERM = true;
    const bf16_t* P; const float* bias; bf16_t* MG;
    __device__ __forceinline__ void operator()(const f32x4 (&acc)[2][2][4][2], const Unit& u) const {
        int t_ = threadIdx.x; asm volatile("" : "+v"(t_)); const int wid_ = __builtin_amdgcn_readfirstlane(t_ >> 6), wr = wid_ >> 2, wc = wid_ & 3, fr = t_ & 15, fq = (t_ >> 4) & 3;
        const int d8 = u.pn * 64 + wc * 16 + 8 * (fq >> 1), bsel = fq & 1;
        f32x4 bv[2][2];
#pragma unroll
        for (int bj = 0; bj < 2; ++bj)
#pragma unroll
            for (int n = 0; n < 2; ++n) bv[bj][n] = *(const f32x4*)(bias + (2 * bsel + bj) * 2048 + d8 + 4 * n) * GATE_PRESCALE;
        const bf16_t* pbase = P + (size_t)u.pm * BM * PLD; bf16_t* mbase = MG + (size_t)u.pm * BM * D;
        const unsigned pcol = (unsigned)((2 * bsel) * 2048 + d8);
        u32x4 pwc[2], pwn[2];
        { const unsigned po = ((unsigned)(wr * 64 + fr) * PLD + pcol) * 2u;
#pragma unroll
          for (int bj = 0; bj < 2; ++bj) pwc[bj] = ld_off<u32x4>(pbase, po + bj * 4096u); }
#pragma unroll
        for (int ai = 0; ai < 2; ++ai)
#pragma unroll
            for (int m = 0; m < 4; ++m) { const unsigned row = (unsigned)(ai * HALF + wr * 64 + m * 16 + fr);
                if (ai * 4 + m < 7) { const int g1 = ai * 4 + m + 1; const unsigned po = ((unsigned)((g1 >> 2) * HALF + wr * 64 + (g1 & 3) * 16 + fr) * PLD + pcol) * 2u;
#pragma unroll
                    for (int bj = 0; bj < 2; ++bj) pwn[bj] = ld_off<u32x4>(pbase, po + bj * 4096u); }
                asm volatile("" ::: "memory");
                float s[8];
#pragma unroll
                for (int e = 0; e < 8; ++e) s[e] = 0.f;
#pragma unroll
                for (int bj = 0; bj < 2; ++bj) { const u32x4 pw = pwc[bj];
#pragma unroll
                    for (int n = 0; n < 2; ++n) { const f32x4 x = acc[ai][bj][m][n] + bv[bj][n]; f32x4 gt;
#pragma unroll
                        for (int j = 0; j < 4; ++j) gt[j] = __builtin_amdgcn_rcpf(1.0f + __builtin_amdgcn_exp2f(x[j]));
                        const unsigned w0 = pw[2 * n], w1 = pw[2 * n + 1];
                        s[4 * n + 0] += gt[0] * bf_lo(w0); s[4 * n + 1] += gt[1] * bf_hi(w0); s[4 * n + 2] += gt[2] * bf_lo(w1); s[4 * n + 3] += gt[3] * bf_hi(w1); } }
#pragma unroll
                for (int e = 0; e < 8; ++e) s[e] += __int_as_float(__builtin_amdgcn_ds_swizzle(__float_as_int(s[e]), 0x401F));
                if (bsel == 0) { u32x4 o; o.x = cvt_pk_bf16(s[0], s[1]); o.y = cvt_pk_bf16(s[2], s[3]); o.z = cvt_pk_bf16(s[4], s[5]); o.w = cvt_pk_bf16(s[6], s[7]);
                    st_off(mbase, (row * D + d8) * 2u, o); }
#pragma unroll
                for (int bj = 0; bj < 2; ++bj) pwc[bj] = pwn[bj]; }
    }
};
struct EpiF32 {
    static constexpr bool APERM = false; static constexpr bool PERM = false;
    float* O; int ldc; size_t sstride;
    __device__ __forceinline__ void operator()(const f32x4 (&acc)[2][2][4][2], const Unit& u) const {
        int t_ = threadIdx.x; asm volatile("" : "+v"(t_)); const int wid_ = __builtin_amdgcn_readfirstlane(t_ >> 6), wr = wid_ >> 2, wc = wid_ & 3, fr = t_ & 15, fq = (t_ >> 4) & 3;
        float* base = O + (size_t)u.pm * sstride + u.pn * BM;
        const unsigned off0 = (unsigned)((wr * 64 + fr) * ldc + wc * 32 + 4 * fq) * 4u;
#pragma unroll
        for (int ai = 0; ai < 2; ++ai)
#pragma unroll
            for (int m = 0; m < 4; ++m) { const unsigned off = off0 + (unsigned)((ai * HALF + m * 16) * ldc) * 4u;
#pragma unroll
                for (int bj = 0; bj < 2; ++bj)
#pragma unroll
                    for (int n = 0; n < 2; ++n) st_off(base, off + (bj * HALF + n * 16) * 4, acc[ai][bj][m][n]); }
    }
};
__device__ __forceinline__ float dpp_prev(float x) { return __int_as_float(__builtin_amdgcn_mov_dpp(__float_as_int(x), 0x121, 0xF, 0xF, false)); }
__device__ __forceinline__ float dpp_next(float x) { return __int_as_float(__builtin_amdgcn_mov_dpp(__float_as_int(x), 0x12F, 0xF, 0xF, false)); }
__device__ __forceinline__ float dpp_prev_e(float edge, float x) { return __int_as_float(__builtin_amdgcn_update_dpp(__float_as_int(edge), __float_as_int(x), 0x111, 0xF, 0xF, false)); }
__device__ __forceinline__ float dpp_next_e(float edge, float x) { return __int_as_float(__builtin_amdgcn_update_dpp(__float_as_int(edge), __float_as_int(x), 0x101, 0xF, 0xF, false)); }
struct EpiUpConv {
    static constexpr bool APERM = true; static constexpr bool PERM = true;
    bf16_t* ACTp; float* SB; const float* fw; LAS float* HL;
    __device__ __forceinline__ void operator()(const f32x4 (&acc)[2][2][4][2], const Unit& u) const {
        int t_ = threadIdx.x; asm volatile("" : "+v"(t_)); const int wid_ = __builtin_amdgcn_readfirstlane(t_ >> 6), wr = wid_ >> 2, wc = wid_ & 3, fr = t_ & 15, fq = (t_ >> 4) & 3;
        const int cl = wc * 32 + 8 * fq, ch0 = u.pn * 128 + cl;
#pragma unroll
        for (int ai = 0; ai < 2; ++ai) {
            if (fr == 0) { LAS float* h = HL + ((ai * 2 + wr) * 2 + 0) * 256 + cl;
                *(LAS f32x4*)h = acc[ai][0][0][0]; *(LAS f32x4*)(h + 4) = acc[ai][0][0][1]; *(LAS f32x4*)(h + 128) = acc[ai][1][0][0]; *(LAS f32x4*)(h + 132) = acc[ai][1][0][1]; }
            if (fr == 15) { LAS float* h = HL + ((ai * 2 + wr) * 2 + 1) * 256 + cl;
                *(LAS f32x4*)h = acc[ai][0][3][0]; *(LAS f32x4*)(h + 4) = acc[ai][0][3][1]; *(LAS f32x4*)(h + 128) = acc[ai][1][3][0]; *(LAS f32x4*)(h + 132) = acc[ai][1][3][1]; }
        }
        asm volatile("s_waitcnt lgkmcnt(0)" ::: "memory"); __builtin_amdgcn_s_barrier(); asm volatile("" ::: "memory");
        bf16_t* abase = ACTp + (size_t)u.pm * BM * FF + u.pn * 128; float* sbase = SB + (size_t)u.pm * 4 * ULD + u.pn * 256;
        u32x2 wkeep[2][4];
#pragma unroll
        for (int n = 0; n < 2; ++n) {
            f32x4 wa[3], wg[3];
#pragma unroll
            for (int dd = 0; dd < 3; ++dd) { wa[dd] = *(const f32x4*)(fw + dd * ULD + ch0 + 4 * n); wg[dd] = *(const f32x4*)(fw + dd * ULD + FF + ch0 + 4 * n); }
#pragma unroll
            for (int ai = 0; ai < 2; ++ai) {
                const int rid_t = (wr == 1) ? ((ai * 2 + 0) * 2 + 1) : (ai == 1 ? 3 : -1), rid_b = (wr == 0) ? ((ai * 2 + 1) * 2 + 0) : (ai == 0 ? 4 : -1);
#pragma unroll
                for (int m = 0; m < 4; ++m) {
                    const unsigned row = (unsigned)(ai * HALF + wr * 64 + 4 * fr + m);
                    f32x4 o;
#pragma unroll
                    for (int j = 0; j < 4; ++j) {
                        float ua, ug;
                        { const float cur = acc[ai][0][m][n][j]; float pv, nx;
                          if (m > 0) pv = acc[ai][0][m - 1][n][j]; else pv = dpp_prev_e((rid_t >= 0) ? HL[rid_t * 256 + cl + 4 * n + j] : 0.f, acc[ai][0][3][n][j]);
                          if (m < 3) nx = acc[ai][0][m + 1][n][j]; else nx = dpp_next_e((rid_b >= 0) ? HL[rid_b * 256 + cl + 4 * n + j] : 0.f, acc[ai][0][0][n][j]);
                          ua = pv * wa[0][j] + cur * wa[1][j] + nx * wa[2][j]; }
                        { const float cur = acc[ai][1][m][n][j]; float pv, nx;
                          if (m > 0) pv = acc[ai][1][m - 1][n][j]; else pv = dpp_prev_e((rid_t >= 0) ? HL[rid_t * 256 + 128 + cl + 4 * n + j] : 0.f, acc[ai][1][3][n][j]);
                          if (m < 3) nx = acc[ai][1][m + 1][n][j]; else nx = dpp_next_e((rid_b >= 0) ? HL[rid_b * 256 + 128 + cl + 4 * n + j] : 0.f, acc[ai][1][0][n][j]);
                          ug = pv * wg[0][j] + cur * wg[1][j] + nx * wg[2][j]; }
                        o[j] = ua * __builtin_amdgcn_rcpf(1.0f + __builtin_amdgcn_exp2f(-1.4426950408889634f * ua)) * ug;
                    }
                    u32x2 w; w.x = cvt_pk_bf16(o[0], o[1]); w.y = cvt_pk_bf16(o[2], o[3]);
                    const bool edge = (row == 0u) || (row == 255u);
                    if (n == 0) wkeep[ai][m] = w;
                    else if (!edge) { u32x4 w4; w4.x = wkeep[ai][m].x; w4.y = wkeep[ai][m].y; w4.z = w.x; w4.w = w.y; st_off(abase, (row * FF + cl) * 2u, w4); }
                    if ((ai == 0 && wr == 0 && fr == 0 && m < 2) || (ai == 1 && wr == 1 && fr == 15 && m >= 2)) { const unsigned k = (unsigned)m;
                        const unsigned so = (k * ULD + cl + 4 * n) * 4u;
                        st_off(sbase, so, acc[ai][0][m][n]); st_off(sbase, so + 512u, acc[ai][1][m][n]); }
                    asm volatile("" ::: "memory");
                }
            }
        }
        asm volatile("s_waitcnt lgkmcnt(0)" ::: "memory");
    }
};
struct EpiResid {
    static constexpr bool APERM = false; static constexpr bool PERM = true;
    const void* base; void* out; const float* gv; int bin, bout;
    __device__ __forceinline__ void operator()(const f32x4 (&acc)[2][2][4][2], const Unit& u) const {
        int t_ = threadIdx.x; asm volatile("" : "+v"(t_)); const int wid_ = __builtin_amdgcn_readfirstlane(t_ >> 6), wr = wid_ >> 2, wc = wid_ & 3, fr = t_ & 15, fq = (t_ >> 4) & 3;
        const size_t pofs = (size_t)u.pm * BM * D; const char* bs_ = (const char*)base + pofs * (bin ? 2 : 4); char* out_ = (char*)out + pofs * (bout ? 2 : 4);
        const int row0 = wr * 64 + fr, col0 = u.pn * BM + wc * 32 + 8 * fq;
        f32x4 g[2][2];
#pragma unroll
        for (int bj = 0; bj < 2; ++bj)
#pragma unroll
            for (int n = 0; n < 2; ++n) g[bj][n] = *(const f32x4*)(gv + col0 + bj * HALF + n * 4);
#define LDB8(dst, eoff) do { if (bin) { const u32x4 w_ = ld_off<u32x4>(bs_, (eoff) * 2u); dst[0] = (f32x4){bf_lo(w_.x), bf_hi(w_.x), bf_lo(w_.y), bf_hi(w_.y)}; dst[1] = (f32x4){bf_lo(w_.z), bf_hi(w_.z), bf_lo(w_.w), bf_hi(w_.w)}; } \
                                  else { dst[0] = ld_off<f32x4>(bs_, (eoff) * 4u); dst[1] = ld_off<f32x4>(bs_, (eoff) * 4u + 16u); } } while (0)
        f32x4 bc[2][2], bn[2][2];
        { const unsigned eo = (unsigned)(row0 * D + col0);
#pragma unroll
          for (int bj = 0; bj < 2; ++bj) LDB8(bc[bj], eo + bj * HALF); }
#pragma unroll
        for (int ai = 0; ai < 2; ++ai)
#pragma unroll
            for (int m = 0; m < 4; ++m) { const unsigned eo = (unsigned)((row0 + ai * HALF + m * 16) * D + col0);
                if (ai * 4 + m < 7) { const int g1 = ai * 4 + m + 1; const unsigned e1 = (unsigned)((row0 + (g1 >> 2) * HALF + (g1 & 3) * 16) * D + col0);
#pragma unroll
                    for (int bj = 0; bj < 2; ++bj) LDB8(bn[bj], e1 + bj * HALF); }
                asm volatile("" ::: "memory");
#pragma unroll
                for (int bj = 0; bj < 2; ++bj) { const f32x4 x0 = bc[bj][0] + g[bj][0] * acc[ai][bj][m][0], x1 = bc[bj][1] + g[bj][1] * acc[ai][bj][m][1]; const unsigned ee = eo + bj * HALF;
                    if (bout) { u32x4 w; w.x = cvt_pk_bf16(x0[0], x0[1]); w.y = cvt_pk_bf16(x0[2], x0[3]); w.z = cvt_pk_bf16(x1[0], x1[1]); w.w = cvt_pk_bf16(x1[2], x1[3]); st_off(out_, ee * 2u, w); }
                    else { st_off(out_, ee * 4u, x0); st_off(out_, ee * 4u + 16u, x1); }
                    bc[bj][0] = bn[bj][0]; bc[bj][1] = bn[bj][1]; } }
#undef LDB8
    }
};

template <class Epi, class Prob, class Sched>
__device__ __forceinline__ void gemm_phase(LAS unsigned char* lds, const Prob& P, const Sched& S, const Epi& E) {
    int tid = threadIdx.x; asm volatile("" : "+v"(tid));
    const int wid = __builtin_amdgcn_readfirstlane(tid >> 6), lane = tid & 63, wr = wid >> 2, wc = wid & 3, fr = lane & 15, fq = lane >> 4;
    unsigned voffA[2], voffB[2];
#pragma unroll
    for (int i = 0; i < 2; ++i) { int R, C; stage_rc(tid * 16 + i * 8192, R, C); const int Rb = Epi::PERM ? ((R & ~31) + perm32(R & 31)) : R;
        const int Ra = Epi::APERM ? ((R & ~63) + 4 * (R & 15) + ((R >> 4) & 3)) : R;
        voffA[i] = (unsigned)(Ra * P.lda + C) * 2u; voffB[i] = (unsigned)(Rb * P.ldb + C) * 2u; }
    const long kstep = (long)(BK * 2);
    const long hA = P.hA, hB = P.hB;
    const unsigned ldsw = (unsigned)wid * 1024u;
    const int aoff = lds_byte(wr * 64 + fr, fq * 8), boff = lds_byte(wc * 32 + fr, fq * 8);
#define PG8_SA(b, h) (((b) * 2 + (h)) * HTB)
#define PG8_SB(b, h) ((4 + (b) * 2 + (h)) * HTB)
    const unsigned ldsm0 = (unsigned)__builtin_amdgcn_readfirstlane((int)(unsigned)(uintptr_t)lds) + ldsw;
#define PG8_STAGE(bufoff, gbase, voff) do { _Pragma("unroll") for (int _i = 0; _i < 2; ++_i) \
        asm volatile("s_mov_b32 m0, %2\n\ts_nop 0\n\tglobal_load_lds_dwordx4 %0, %1" :: "v"((voff)[_i]), "s"((const char*)(gbase)), "s"(ldsm0 + (unsigned)((bufoff) + _i * 8192)) : "memory", "m0"); } while (0)
#define PG8_LDA(dst, b, h) do { _Pragma("unroll") for (int m = 0; m < 4; ++m) _Pragma("unroll") for (int k = 0; k < 2; ++k) dst[m][k] = *(const LAS bf16x8*)(lds + PG8_SA(b, h) + aoff + m * 2048 + k * 1024); } while (0)
#define PG8_LDB(dst, b, h) do { _Pragma("unroll") for (int n = 0; n < 2; ++n) _Pragma("unroll") for (int k = 0; k < 2; ++k) dst[n][k] = *(const LAS bf16x8*)(lds + PG8_SB(b, h) + boff + n * 2048 + k * 1024); } while (0)
#define PG8_MMA(ai, bj, At, Bt) do { __builtin_amdgcn_s_setprio(1); _Pragma("unroll") for (int m = 0; m < 4; ++m) _Pragma("unroll") for (int n = 0; n < 2; ++n) _Pragma("unroll") for (int k = 0; k < 2; ++k) \
        acc[ai][bj][m][n] = __builtin_amdgcn_mfma_f32_16x16x32_bf16(Bt[n][k], At[m][k], acc[ai][bj][m][n], 0, 0, 0); __builtin_amdgcn_s_setprio(0); } while (0)
#define PG8_MMAZ(ai, bj, At, Bt) do { __builtin_amdgcn_s_setprio(1); _Pragma("unroll") for (int m = 0; m < 4; ++m) _Pragma("unroll") for (int n = 0; n < 2; ++n) { \
        acc[ai][bj][m][n] = __builtin_amdgcn_mfma_f32_16x16x32_bf16(Bt[n][0], At[m][0], (f32x4){0.f, 0.f, 0.f, 0.f}, 0, 0, 0); \
        acc[ai][bj][m][n] = __builtin_amdgcn_mfma_f32_16x16x32_bf16(Bt[n][1], At[m][1], acc[ai][bj][m][n], 0, 0, 0); } __builtin_amdgcn_s_setprio(0); } while (0)
#define PG8_WAIT_V(n) asm volatile("s_waitcnt vmcnt(" #n ")" ::: "memory")
#define PG8_WAIT_L(n) asm volatile("s_waitcnt lgkmcnt(" #n ")" ::: "memory")
#define PG8_BAR __builtin_amdgcn_s_barrier()
#define PG8_SCHED __builtin_amdgcn_sched_barrier(0)
    Unit cur, nxt; int ui = 0;
    if (!S.next(0, cur)) return;
    f32x4 acc[2][2][4][2];
    bf16x8 At[4][2], B0[2][2], B1[2][2];
    const char* cA; const char* cB; int nt;
    P.locate(cur, cA, cB, nt);
    PG8_STAGE(PG8_SB(0, 0), cB, voffB); PG8_STAGE(PG8_SB(0, 1), cB + hB, voffB); PG8_STAGE(PG8_SA(0, 0), cA, voffA); PG8_STAGE(PG8_SA(0, 1), cA + hA, voffA);
    if (wr == 1) PG8_BAR;
    PG8_WAIT_V(2); PG8_BAR;
    PG8_STAGE(PG8_SB(1, 0), cB + kstep, voffB); PG8_STAGE(PG8_SA(1, 0), cA + kstep, voffA); PG8_STAGE(PG8_SB(1, 1), cB + hB + kstep, voffB);
    PG8_WAIT_V(6); PG8_BAR;
    for (;;) {
        const bool has_next = S.next(ui + 1, nxt);
        const char* nA = cA; const char* nB = cB; int nnt = nt;
        if (has_next) P.locate(nxt, nA, nB, nnt);
#define PG8_KSTEP(MM) do { \
            const bool last = (t == nt - 2); \
            const char* a1 = cA + (long)(t + 1) * kstep; \
            const char* a2 = last ? nA : cA + (long)(t + 2) * kstep; const char* b2 = last ? nB : cB + (long)(t + 2) * kstep; \
            const char* a3 = a2 + kstep; const char* b3 = b2 + kstep; \
            PG8_LDB(B0, 0, 0); PG8_LDB(B1, 0, 1); PG8_SCHED; PG8_LDA(At, 0, 0); PG8_STAGE(PG8_SA(1, 1), a1 + hA, voffA); \
            PG8_WAIT_V(8); PG8_WAIT_L(0); PG8_BAR; MM(0, 0, At, B0); MM(0, 1, At, B1); PG8_BAR; PG8_SCHED; \
            PG8_LDA(At, 0, 1); PG8_STAGE(PG8_SB(0, 0), b2, voffB); PG8_STAGE(PG8_SB(0, 1), b2 + hB, voffB); PG8_STAGE(PG8_SA(0, 0), a2, voffA); \
            PG8_WAIT_V(8); PG8_WAIT_L(0); PG8_BAR; MM(1, 0, At, B0); MM(1, 1, At, B1); PG8_BAR; PG8_SCHED; \
            PG8_LDB(B0, 1, 0); PG8_LDB(B1, 1, 1); PG8_SCHED; PG8_LDA(At, 1, 0); PG8_STAGE(PG8_SA(0, 1), a2 + hA, voffA); \
            PG8_WAIT_V(8); PG8_WAIT_L(0); PG8_BAR; PG8_MMA(0, 0, At, B0); PG8_MMA(0, 1, At, B1); PG8_BAR; PG8_SCHED; \
            PG8_LDA(At, 1, 1); PG8_STAGE(PG8_SB(1, 0), b3, voffB); PG8_STAGE(PG8_SB(1, 1), b3 + hB, voffB); PG8_STAGE(PG8_SA(1, 0), a3, voffA); \
            PG8_WAIT_V(8); PG8_WAIT_L(0); PG8_BAR; PG8_MMA(1, 0, At, B0); PG8_MMA(1, 1, At, B1); PG8_BAR; PG8_SCHED; } while (0)
        { int t = 0; PG8_KSTEP(PG8_MMAZ);
          for (t = 2; t < nt; t += 2) PG8_KSTEP(PG8_MMA); }
#undef PG8_KSTEP
        if (wr == 0) PG8_BAR;
        E(acc, cur);
        if (!has_next) break;
        cur = nxt; cA = nA; cB = nB; nt = nnt; ++ui;
        if (wr == 1) PG8_BAR;
    }
    PG8_WAIT_V(0);
    PG8_BAR;
#undef PG8_SA
#undef PG8_SB
#undef PG8_STAGE
#undef PG8_LDA
#undef PG8_LDB
#undef PG8_MMA
#undef PG8_MMAZ
#undef PG8_WAIT_V
#undef PG8_WAIT_L
#undef PG8_BAR
#undef PG8_SCHED
}
}

namespace att {
constexpr int NW = 8, QBLK = 32, KVBLK = 64;
constexpr float SCALE = 0.088388347648318440f;
constexpr float THR = 8.f;
constexpr float NEGV = -1.0e30f;
constexpr size_t SHM_V = KVBLK * 128 * 2, SHM_K = KVBLK * 128 * 2, SHM_ATTN = 2 * SHM_V + 2 * SHM_K + NW * 64 * 4, SHM_BIAS = SHM_ATTN;
#define KSWZ(row, colB) ((row) * 256 + ((colB) ^ (((row) & 7) << 4)))
#define SBAR() __builtin_amdgcn_sched_barrier(0)
__device__ __forceinline__ int crow(int r, int hi) { return (r & 3) + 8 * (r >> 2) + 4 * hi; }
__device__ __forceinline__ void partialSM(f32x16& p0) {
  for (int r = 0; r < 16; ++r) p0[r] = __builtin_amdgcn_exp2f(p0[r]);
}
__device__ __forceinline__ void finishSM(f32x16& p0, f32x16& p1, float& l_reg, bf16x8& pa0, bf16x8& pa1, bf16x8& pa2, bf16x8& pa3) {
  for (int r = 0; r < 16; ++r) p1[r] = __builtin_amdgcn_exp2f(p1[r]);
  float ps = 0; for (int r = 0; r < 16; ++r) ps += p0[r]; for (int r = 0; r < 16; ++r) ps += p1[r];
  l_reg += ps;
#define PK4(P, BASE, OUT) do { unsigned a0 = cvt_pk_bf16(P[BASE + 0], P[BASE + 1]), a1 = cvt_pk_bf16(P[BASE + 2], P[BASE + 3]);   \
    unsigned b0 = cvt_pk_bf16(P[BASE + 4], P[BASE + 5]), b1 = cvt_pk_bf16(P[BASE + 6], P[BASE + 7]);                              \
    auto r0 = __builtin_amdgcn_permlane32_swap(a0, b0, false, false); auto r1 = __builtin_amdgcn_permlane32_swap(a1, b1, false, false); \
    u32x4 w = {r0[0], r1[0], r0[1], r1[1]}; OUT = *reinterpret_cast<bf16x8*>(&w); } while (0)
  PK4(p0, 0, pa0); PK4(p0, 8, pa1); PK4(p1, 0, pa2); PK4(p1, 8, pa3);
#undef PK4
}
__device__ __forceinline__ void qkt(f32x16& p0, f32x16& p1, const bf16_t* Ks, const bf16x8* qr, int r32, int hi, const f32x16& seed) {
  for (int d0 = 0; d0 < 8; ++d0) { int cb = (d0 * 16 + hi * 8) * 2;
    bf16x8 b0 = *reinterpret_cast<const bf16x8*>((const char*)Ks + KSWZ(r32, cb));
    bf16x8 b1 = *reinterpret_cast<const bf16x8*>((const char*)Ks + KSWZ(32 + r32, cb));
    p0 = __builtin_amdgcn_mfma_f32_32x32x16_bf16(b0, qr[d0], d0 == 0 ? seed : p0, 0, 0, 0);
    p1 = __builtin_amdgcn_mfma_f32_32x32x16_bf16(b1, qr[d0], d0 == 0 ? seed : p1, 0, 0, 0); }
}
__device__ __forceinline__ int v_st(int k, int c) { const int kk = (k & ~0xC) | ((k & 4) << 1) | ((k & 8) >> 1); return ((kk >> 3) * 4 + (c >> 5)) * 512 + ((kk & 7) * 32 + (c & 31)) * 2; }
__device__ __forceinline__ int v_rd_base(int lane) { return ((lane & 3) << 3) | (((lane >> 2) & 3) << 6) | (((lane >> 4) & 1) << 5) | (((lane >> 5) & 1) << 8); }
constexpr int v_rd_off(int d0, int ks, int half) { return d0 * 512 + ks * 4096 + half * 2048; }
template <int OFF> __device__ __forceinline__ s16x4 tr_read(int vb) {
  s16x4 r; asm volatile("ds_read_b64_tr_b16 %0, %1 offset:%2" : "=&v"(r) : "v"(vb), "i"(OFF) : "memory"); return r;
}
template <int D0> __device__ __forceinline__ void pv_one(f32x16& od, int vb, bf16x8 pa0, bf16x8 pa1, bf16x8 pa2, bf16x8 pa3) {
  const s16x4 l0 = tr_read<v_rd_off(D0, 0, 0)>(vb), h0 = tr_read<v_rd_off(D0, 0, 1)>(vb), l1 = tr_read<v_rd_off(D0, 1, 0)>(vb), h1 = tr_read<v_rd_off(D0, 1, 1)>(vb);
  const s16x4 l2 = tr_read<v_rd_off(D0, 2, 0)>(vb), h2 = tr_read<v_rd_off(D0, 2, 1)>(vb), l3 = tr_read<v_rd_off(D0, 3, 0)>(vb), h3 = tr_read<v_rd_off(D0, 3, 1)>(vb);
  asm volatile("s_waitcnt lgkmcnt(0)" ::: "memory"); SBAR();
#define PK(L, H) (bf16x8){L[0], L[1], L[2], L[3], H[0], H[1], H[2], H[3]}
  od = __builtin_amdgcn_mfma_f32_32x32x16_bf16(PK(l0, h0), pa0, od, 0, 0, 0);
  od = __builtin_amdgcn_mfma_f32_32x32x16_bf16(PK(l1, h1), pa1, od, 0, 0, 0);
  od = __builtin_amdgcn_mfma_f32_32x32x16_bf16(PK(l2, h2), pa2, od, 0, 0, 0);
  od = __builtin_amdgcn_mfma_f32_32x32x16_bf16(PK(l3, h3), pa3, od, 0, 0, 0);
#undef PK
}
__device__ __forceinline__ void pv_d0(f32x16* o, int vb, bf16x8 pa0, bf16x8 pa1, bf16x8 pa2, bf16x8 pa3) {
  pv_one<0>(o[0], vb, pa0, pa1, pa2, pa3); pv_one<1>(o[1], vb, pa0, pa1, pa2, pa3); pv_one<2>(o[2], vb, pa0, pa1, pa2, pa3); pv_one<3>(o[3], vb, pa0, pa1, pa2, pa3);
}
__device__ __forceinline__ void na_mask(f32x16& p0, f32x16& p1, int kr, int rq, int r0q, int cq, int c0q, const float* bias, int hi) {
  const bool rowok = (kr >= r0q) && (kr <= r0q + 7);
  if (!rowok) {
    for (int r = 0; r < 16; ++r) { p0[r] = NEGV; p1[r] = NEGV; }
  } else {
    const float* bp = bias + (kr - rq + 7) * 31 + (15 - cq);
#pragma unroll
    for (int r = 0; r < 16; ++r) { const int kc0 = crow(r, hi), kc1 = kc0 + 32;
      const bool v0 = (kc0 >= c0q) && (kc0 <= c0q + 15), v1 = (kc1 >= c0q) && (kc1 <= c0q + 15);
      const float b0 = bp[v0 ? kc0 : cq], b1 = bp[v1 ? kc1 : cq];
      p0[r] = v0 ? p0[r] + b0 : NEGV; p1[r] = v1 ? p1[r] + b1 : NEGV;
      if ((r & 3) == 3) SBAR(); }
  }
}
__device__ __forceinline__ void attn_body(const bf16_t* __restrict__ Qb, const bf16_t* __restrict__ Kh, const bf16_t* __restrict__ Vh, bf16_t* __restrict__ Ob,
                                          int NT, int ldq, int ldk, int ldo, char* lds, float negM) {
  int tid = threadIdx.x; asm volatile("" : "+v"(tid));
  const int wid = tid >> 6, lane = tid & 63, r32 = lane & 31, hi = lane >> 5;
  bf16_t* V_lds = (bf16_t*)lds; bf16_t* K_lds = (bf16_t*)(lds + 2 * SHM_V);
  float* ws = (float*)(lds + 2 * SHM_V + 2 * SHM_K) + wid * 64; float* li_l = ws;
  float l_reg = 0; f32x16 o[4] = {}; bf16x8 qr[8];
  const bf16_t* Qw = Qb + (long)(wid * QBLK + r32) * ldq + hi * 8;
#pragma unroll
  for (int d0 = 0; d0 < 8; ++d0) qr[d0] = *reinterpret_cast<const bf16x8*>(Qw + d0 * 16);
  const int sr = tid >> 4, sc = (tid & 15) * 8, vst0 = v_st(sr, sc), vst1 = v_st(32 + sr, sc);
  const int vb0 = (int)(uintptr_t)V_lds + v_rd_base(lane);
  const unsigned lofs = (unsigned)(sr * ldk + sc) * 2u;
  const char* Kc0 = (const char*)Kh; const char* Vc0 = (const char*)Vh;
  const size_t tstep = (size_t)64 * ldk * 2, hstep = (size_t)32 * ldk * 2;
  struct { bf16x8 vs0, vs1, ks0, ks1; } sr_[1];
#define SLOAD(i, jt) do { const char* vb_ = Vc0 + (size_t)(jt) * tstep; const char* kb_ = Kc0 + (size_t)(jt) * tstep; unsigned lo_ = lofs; asm volatile("" : "+v"(lo_));   \
    sr_[i].vs0 = ld_off<bf16x8>(vb_, lo_); sr_[i].vs1 = ld_off<bf16x8>(vb_ + hstep, lo_); sr_[i].ks0 = ld_off<bf16x8>(kb_, lo_); sr_[i].ks1 = ld_off<bf16x8>(kb_ + hstep, lo_); } while (0)
#define SWRITE(b, i) do { *(bf16x8*)((char*)V_lds + (b) * SHM_V + vst0) = sr_[i].vs0;          \
    *(bf16x8*)((char*)V_lds + (b) * SHM_V + vst1) = sr_[i].vs1; int kc = sc * 2;               \
    *(bf16x8*)((char*)K_lds + (b) * SHM_K + KSWZ(sr, kc)) = sr_[i].ks0;                       \
    *(bf16x8*)((char*)K_lds + (b) * SHM_K + KSWZ(32 + sr, kc)) = sr_[i].ks1; } while (0)
#define SWAIT() asm volatile("s_waitcnt vmcnt(0)" ::: "memory")
  f32x16 pA0, pA1, pB0, pB1; bf16x8 pa0, pa1, pa2, pa3;
  f32x16 seed; for (int r = 0; r < 16; ++r) seed[r] = negM; asm volatile("" : "+v"(seed));
  constexpr int SE = 0, SO = 0;
  SLOAD(SE, 0); asm volatile("s_waitcnt vmcnt(0)" ::: "memory"); SWRITE(0, SE); __syncthreads();
  qkt(pA0, pA1, K_lds, qr, r32, hi, seed); partialSM(pA0);
  SLOAD(SO, 1);
  SWAIT(); SWRITE(1, SO); __syncthreads();
  for (int j = 1; j + 1 < NT; j += 2) {
    SBAR(); qkt(pB0, pB1, (bf16_t*)((char*)K_lds + SHM_K), qr, r32, hi, seed);
    finishSM(pA0, pA1, l_reg, pa0, pa1, pa2, pa3); SBAR();
    SLOAD(SO, j + 1); SBAR();
    pv_d0(o, vb0, pa0, pa1, pa2, pa3); partialSM(pB0);
    __syncthreads(); SWAIT(); SWRITE(0, SE);
    __syncthreads();
    SBAR(); qkt(pA0, pA1, K_lds, qr, r32, hi, seed);
    finishSM(pB0, pB1, l_reg, pa0, pa1, pa2, pa3); SBAR();
    SLOAD(SE, j + 2); SBAR();
    pv_d0(o, vb0 + (int)SHM_V, pa0, pa1, pa2, pa3); partialSM(pA0);
    __syncthreads(); SWAIT(); SWRITE(1, SO);
    __syncthreads();
  }
  SBAR(); qkt(pB0, pB1, (bf16_t*)((char*)K_lds + SHM_K), qr, r32, hi, seed);
  finishSM(pA0, pA1, l_reg, pa0, pa1, pa2, pa3); SBAR();
  pv_d0(o, vb0, pa0, pa1, pa2, pa3); partialSM(pB0);
  __syncthreads();
  finishSM(pB0, pB1, l_reg, pa0, pa1, pa2, pa3); SBAR();
  pv_d0(o, vb0 + (int)SHM_V, pa0, pa1, pa2, pa3);
  { auto rr = __builtin_amdgcn_permlane32_swap(__float_as_uint(l_reg), __float_as_uint(l_reg), false, false); l_reg = __uint_as_float(rr[0]) + __uint_as_float(rr[1]); }
  const float rl = __builtin_amdgcn_rcpf(l_reg);
  char* Ow = (char*)(Ob + (long)(wid * QBLK) * ldo);
  int te_ = threadIdx.x; asm volatile("" : "+v"(te_));
  const unsigned oofs = (unsigned)((te_ & 31) * ldo + 8 * ((te_ >> 5) & 1)) * 2u;
#pragma unroll
  for (int d0 = 0; d0 < 4; ++d0)
#pragma unroll
    for (int k = 0; k < 4; k += 2) {
      const unsigned a0 = cvt_pk_bf16(o[d0][4 * k + 0] * rl, o[d0][4 * k + 1] * rl), a1 = cvt_pk_bf16(o[d0][4 * k + 2] * rl, o[d0][4 * k + 3] * rl);
      const unsigned b0 = cvt_pk_bf16(o[d0][4 * k + 4] * rl, o[d0][4 * k + 5] * rl), b1 = cvt_pk_bf16(o[d0][4 * k + 6] * rl, o[d0][4 * k + 7] * rl);
      auto s0 = __builtin_amdgcn_permlane32_swap(a0, b0, false, false); auto s1 = __builtin_amdgcn_permlane32_swap(a1, b1, false, false);
      u32x4 w = {s0[0], s1[0], s0[1], s1[1]};
      st_off(Ow, oofs + (unsigned)(d0 * 32 + 8 * k) * 2u, w); }
  __syncthreads();
#undef SLOAD
#undef SWAIT
}
__device__ __forceinline__ void attn_na(const bf16_t* __restrict__ Qb, const bf16_t* __restrict__ Kh, const bf16_t* __restrict__ Vh, bf16_t* __restrict__ Ob,
                                        int ldq, int ldk, int ldo, char* lds, int na_lo, int na_r0, const float* rpb, float qkbound) {
  int tid = threadIdx.x; asm volatile("" : "+v"(tid));
  const int wid = tid >> 6, lane = tid & 63, r32 = lane & 31, hi = lane >> 5;
  bf16_t* V_lds = (bf16_t*)lds; bf16_t* K_lds = (bf16_t*)(lds + 2 * SHM_V);
  float* ws = (float*)(lds + 2 * SHM_V + 2 * SHM_K) + wid * 64; float* li_l = ws;
  float* bias_l = (float*)(lds + SHM_BIAS);
  const int rq = na_r0 + (wid >> 1), cq = 32 * (wid & 1) + r32;
  const int r0q = min(max(rq - 4, 0), 248), c0q = min(max(cq - 8, 0), 48);
  const int r0u = __builtin_amdgcn_readfirstlane(r0q);
  if (tid < 465) bias_l[tid] = rpb[tid] * 1.4426950408889634f;
  float bmax = 0.f;
#pragma unroll
  for (int i = 0; i < 8; ++i) { const int idx = lane + 64 * i; bmax = fmaxf(bmax, idx < 465 ? fabsf(rpb[idx]) : 0.f); }
#pragma unroll
  for (int o_ = 1; o_ < 64; o_ <<= 1) bmax = fmaxf(bmax, __int_as_float(__builtin_amdgcn_ds_bpermute((lane ^ o_) << 2, __float_as_int(bmax))));
  const float negM = -(qkbound * (SCALE * 1.4426950408889634f) + bmax * 1.4426950408889634f);
  float l_reg = 0; f32x16 o[4] = {}; bf16x8 qr[8];
  const bf16_t* Qw = Qb + (long)(wid * QBLK + r32) * ldq + hi * 8;
#pragma unroll
  for (int d0 = 0; d0 < 8; ++d0) qr[d0] = *reinterpret_cast<const bf16x8*>(Qw + d0 * 16);
  const int sr = tid >> 4, sc = (tid & 15) * 8, vst0 = v_st(sr, sc), vst1 = v_st(32 + sr, sc);
  const int vb0 = (int)(uintptr_t)V_lds + v_rd_base(lane);
  const unsigned lofs = (unsigned)(sr * ldk + sc) * 2u;
  const char* Kc0 = (const char*)Kh; const char* Vc0 = (const char*)Vh;
  const size_t rstep = (size_t)ldk * 2, hstep = (size_t)32 * ldk * 2;
  bf16x8 vs0, vs1, ks0, ks1;
#define KROW(j) ((j) < 4 ? SEQ + 64 * (j) : 64 * (na_lo + (j) - 4))
#define NLOAD(jt) do { const size_t ko_ = (size_t)KROW(jt) * rstep; unsigned lo_ = lofs; asm volatile("" : "+v"(lo_)); vs0 = ld_off<bf16x8>(Vc0 + ko_, lo_); vs1 = ld_off<bf16x8>(Vc0 + ko_ + hstep, lo_); ks0 = ld_off<bf16x8>(Kc0 + ko_, lo_); ks1 = ld_off<bf16x8>(Kc0 + ko_ + hstep, lo_); } while (0)
#define NWRITE(b) do { *(bf16x8*)((char*)V_lds + (b) * SHM_V + vst0) = vs0; *(bf16x8*)((char*)V_lds + (b) * SHM_V + vst1) = vs1; int kc = sc * 2;               \
    *(bf16x8*)((char*)K_lds + (b) * SHM_K + KSWZ(sr, kc)) = ks0; *(bf16x8*)((char*)K_lds + (b) * SHM_K + KSWZ(32 + sr, kc)) = ks1; } while (0)
  NLOAD(0); asm volatile("s_waitcnt vmcnt(0)" ::: "memory"); NWRITE(0); __syncthreads();
  for (int j = 0; j < 16; ++j) {
    const int b = j & 1;
    if (j + 1 < 16) NLOAD(j + 1);
    const int kr_ = na_lo + j - 4;
    if (j < 4 || (kr_ >= r0u && kr_ <= r0u + 7)) {
      f32x16 p0, p1; bf16x8 pa0, pa1, pa2, pa3;
      SBAR(); qkt(p0, p1, (bf16_t*)((char*)K_lds + b * SHM_K), qr, r32, hi, f32x16{});
      if (j >= 4) na_mask(p0, p1, kr_, rq, r0q, cq, c0q, bias_l, hi);
      for (int r = 0; r < 16; ++r) p0[r] += negM; for (int r = 0; r < 16; ++r) p1[r] += negM;
      partialSM(p0);
      finishSM(p0, p1, l_reg, pa0, pa1, pa2, pa3); SBAR();
      pv_d0(o, vb0 + b * (int)SHM_V, pa0, pa1, pa2, pa3);
    }
    if (j + 1 < 16) { asm volatile("s_waitcnt vmcnt(0)" ::: "memory"); NWRITE(b ^ 1); }
    __syncthreads();
  }
  { auto rr = __builtin_amdgcn_permlane32_swap(__float_as_uint(l_reg), __float_as_uint(l_reg), false, false); l_reg = __uint_as_float(rr[0]) + __uint_as_float(rr[1]); }
  const float rl = __builtin_amdgcn_rcpf(l_reg);
  char* Ow = (char*)(Ob + (long)(wid * QBLK) * ldo);
  int te_ = threadIdx.x; asm volatile("" : "+v"(te_));
  const unsigned oofs = (unsigned)((te_ & 31) * ldo + 8 * ((te_ >> 5) & 1)) * 2u;
#pragma unroll
  for (int d0 = 0; d0 < 4; ++d0)
#pragma unroll
    for (int k = 0; k < 4; k += 2) {
      const unsigned a0 = cvt_pk_bf16(o[d0][4 * k + 0] * rl, o[d0][4 * k + 1] * rl), a1 = cvt_pk_bf16(o[d0][4 * k + 2] * rl, o[d0][4 * k + 3] * rl);
      const unsigned b0 = cvt_pk_bf16(o[d0][4 * k + 4] * rl, o[d0][4 * k + 5] * rl), b1 = cvt_pk_bf16(o[d0][4 * k + 6] * rl, o[d0][4 * k + 7] * rl);
      auto s0 = __builtin_amdgcn_permlane32_swap(a0, b0, false, false); auto s1 = __builtin_amdgcn_permlane32_swap(a1, b1, false, false);
      u32x4 w = {s0[0], s1[0], s0[1], s1[1]};
      st_off(Ow, oofs + (unsigned)(d0 * 32 + 8 * k) * 2u, w); }
  __syncthreads();
#undef KROW
#undef NLOAD
#undef NWRITE
#undef SWRITE
}
}

struct Args { const float* in[25]; float* out; unsigned char* ws; int ph_lo, ph_hi; };
enum { I_X = 0, I_C, I_CTX, I_CCTX, I_WADA, I_BADA, I_NORM1, I_WIN, I_CONVW, I_NAQG, I_NAKG, I_RPB, I_GQG, I_GKG, I_WCO, I_WFO, I_WNO, I_WGO, I_WGATE, I_BGATE, I_WO, I_NORM2, I_WUP, I_FCW, I_WDOWN };

__device__ __forceinline__ int rowmap(int mode, int n) {
    if (mode == 1) { const int zc = n < 1536 ? n : n - 512;
        if (zc < 3072 || zc >= 4352) return zc;
        const int d = zc & 127, nn = d >> 6, p = d & 63; return (zc & ~127) + 32 * (p >> 4) + 8 * ((p >> 2) & 3) + 4 * nn + (p & 3); }
    if (mode == 2) { const int b = n >> 11, d = n & 2047; return 256 * (d >> 6) + 128 * (b & 1) + 32 * ((d >> 4) & 3) + 8 * (2 * ((d >> 3) & 1) + (b >> 1)) + (d & 7); }
    if (mode == 3) { const int g = n >= FF, ch = g ? n - FF : n; return 256 * (ch >> 7) + 128 * g + (ch & 127); }
    return n;
}
__device__ __forceinline__ void transpose_item(const float* W, int ldw, int k0, int n0, bf16_t* WT, int ldd, int koff, int mode, LAS float* scr, int lane) {
    const int kk = lane >> 3, q = lane & 7;
    f32x4 v[16];
#pragma unroll
    for (int h = 0; h < 2; ++h)
#pragma unroll
        for (int i = 0; i < 8; ++i) v[h * 8 + i] = *(const f32x4*)(W + (size_t)(k0 + 8 * i + kk) * ldw + n0 + 32 * h + 4 * q);
    const int c = lane & 7;
#pragma unroll
    for (int h = 0; h < 2; ++h) {
#pragma unroll
        for (int i = 0; i < 8; ++i)
#pragma unroll
            for (int e = 0; e < 4; ++e) scr[(8 * i + kk) * 33 + 4 * q + e] = v[h * 8 + i][e];
        LDS_WAIT(); asm volatile("" ::: "memory");
#pragma unroll
        for (int j = 0; j < 4; ++j) { const int n = (lane >> 3) + 8 * j; const LAS float* s = scr + (8 * c) * 33 + n;
            const float ws_ = (mode == 2) ? GATE_PRESCALE : 1.0f;
            u32x4 o; o.x = cvt_pk_bf16(s[0 * 33] * ws_, s[1 * 33] * ws_); o.y = cvt_pk_bf16(s[2 * 33] * ws_, s[3 * 33] * ws_); o.z = cvt_pk_bf16(s[4 * 33] * ws_, s[5 * 33] * ws_); o.w = cvt_pk_bf16(s[6 * 33] * ws_, s[7 * 33] * ws_);
            *(u32x4*)(WT + (size_t)rowmap(mode, n0 + 32 * h + n) * ldd + koff + k0 + 8 * c) = o; }
        LDS_WAIT(); asm volatile("" ::: "memory");
    }
}
__device__ __forceinline__ void copy_item(const float* W, int ldw, int k0, int n0, bf16_t* dst, int ldd, int nd0, int lane) {
#pragma unroll 8
    for (int i = 0; i < 32; ++i) { const int kk = 2 * i + (lane >> 5); const float v = W[(size_t)(k0 + kk) * ldw + n0 + (lane & 31)];
        dst[(size_t)(k0 + kk) * ldd + nd0 + (lane & 31)] = (bf16_t)(cvt_pk_bf16(v, 0.f) & 0xffffu); }
}

__device__ __forceinline__ const void* uptr(const LAS unsigned long long* tab, int i) {
    const unsigned long long v = tab[i]; const unsigned lo = __builtin_amdgcn_readfirstlane((unsigned)v), hi = __builtin_amdgcn_readfirstlane((unsigned)(v >> 32));
    return (const void*)(const GAS void*)(((unsigned long long)hi << 32) | lo); }
__device__ __forceinline__ unsigned noff(int lane, int j) { return (unsigned)(j >> 1) * 2048u + (unsigned)lane * 32u + (unsigned)(j & 1) * 16u; }
__device__ __forceinline__ void st_wt16(void* base, unsigned off, u32x4 v) {
    asm volatile("global_store_dwordx4 %0, %1, %2 sc1\n\ts_nop 1" :: "v"(off), "v"(v), "s"(base) : "memory"); }
__device__ __forceinline__ void norm_prep(const float* gain, const float* mod, int shi, int lane, f32x4 (&G)[8], f32x4 (&S)[8]) {
#pragma unroll
    for (int j = 0; j < 8; ++j) { const unsigned o = noff(lane, j); const f32x4 g = ld_off<f32x4>(gain, o), sc = ld_off<f32x4>(mod + shi + D, o); S[j] = ld_off<f32x4>(mod + shi, o); G[j] = g * (sc + 1.0f); }
}
__device__ __forceinline__ void norm_finish(f32x4 (&v)[8], const f32x4 (&G)[8], const f32x4 (&S)[8], bf16_t* orow, int lane) {
    float ss = 0.f;
#pragma unroll
    for (int j = 0; j < 8; ++j) ss += (v[j].x * v[j].x + v[j].y * v[j].y) + (v[j].z * v[j].z + v[j].w * v[j].w);
    const float rstd = 1.0f / sqrtf(wave_sum(ss, lane) * (1.0f / D) + EPS);
#pragma unroll
    for (int k = 0; k < 4; ++k) { const f32x4 o0 = (v[2 * k] * rstd) * G[2 * k] + S[2 * k], o1 = (v[2 * k + 1] * rstd) * G[2 * k + 1] + S[2 * k + 1];
        u32x4 w; w.x = cvt_pk_bf16(o0.x, o0.y); w.y = cvt_pk_bf16(o0.z, o0.w); w.z = cvt_pk_bf16(o1.x, o1.y); w.w = cvt_pk_bf16(o1.z, o1.w);
        st_wt16(orow, (unsigned)k * 1024u + (unsigned)lane * 16u, w); }
}
__device__ __forceinline__ void norm_lat_rows(const void* hL, int hbf, int lr0, int nlat, const float* gain, const float* modL, int shi, bf16_t* XN, int lane) {
    f32x4 G[8], S[8]; norm_prep(gain, modL, shi, lane, G, S);
    for (int i = 0; i < nlat; ++i) { const int r = lr0 + i; const char* xrow = (const char*)hL + (size_t)r * D * (hbf ? 2 : 4); f32x4 v[8];
        if (hbf) {
#pragma unroll
            for (int k = 0; k < 4; ++k) { const u32x4 w = ld_off<u32x4>(xrow, (unsigned)k * 1024u + (unsigned)lane * 16u);
                v[2 * k] = (f32x4){bf_lo(w.x), bf_hi(w.x), bf_lo(w.y), bf_hi(w.y)}; v[2 * k + 1] = (f32x4){bf_lo(w.z), bf_hi(w.z), bf_lo(w.w), bf_hi(w.w)}; }
        } else {
#pragma unroll
            for (int j = 0; j < 8; ++j) v[j] = ld_off<f32x4>(xrow, noff(lane, j)); }
        norm_finish(v, G, S, XN + (size_t)r * D, lane); }
}
__device__ __forceinline__ void norm_ctx_row(int crow, const float* cbase, const float* part, int ns, const float* cg, float* HC, const float* gain, const float* modC, int shi, bf16_t* XN, int lane) {
    const float* xrow = cbase + (size_t)crow * D; f32x4 v[8];
#pragma unroll
    for (int j = 0; j < 8; ++j) v[j] = ld_off<f32x4>(xrow, noff(lane, j));
    if (ns > 0) {
        f32x4 a[8];
#pragma unroll
        for (int j = 0; j < 8; ++j) a[j] = (f32x4){0.f, 0.f, 0.f, 0.f};
        int s = 0;
        for (; s + 2 <= ns; s += 2) { const float* p0 = part + ((size_t)s * 256 + crow) * D; const float* p1 = p0 + (size_t)256 * D; f32x4 t[2][8];
#pragma unroll
            for (int j = 0; j < 8; ++j) { t[0][j] = ld_off<f32x4>(p0, noff(lane, j)); t[1][j] = ld_off<f32x4>(p1, noff(lane, j)); }
#pragma unroll
            for (int j = 0; j < 8; ++j) a[j] += t[0][j] + t[1][j]; }
        for (; s < ns; ++s) { const float* p0 = part + ((size_t)s * 256 + crow) * D;
#pragma unroll
            for (int j = 0; j < 8; ++j) a[j] += ld_off<f32x4>(p0, noff(lane, j)); }
        float* hc = HC + (size_t)crow * D;
#pragma unroll
        for (int j = 0; j < 8; ++j) { v[j] += ld_off<f32x4>(cg, noff(lane, j)) * a[j]; st_off(hc, noff(lane, j), v[j]); }
    }
    f32x4 G[8], S[8]; norm_prep(gain, modC, shi, lane, G, S);
    norm_finish(v, G, S, XN + (size_t)(SEQ + crow) * D, lane);
}
template <bool CTX, int NR>
__device__ __forceinline__ void ffn_conv_rows(const bf16_t* U, const float* PU, const float* fw, bf16_t* A, int t0, int ch, bool hasp, bool hasn) {
    float wa[3][8], wg[3][8];
#pragma unroll
    for (int dd = 0; dd < 3; ++dd)
#pragma unroll
        for (int e = 0; e < 8; ++e) { wa[dd][e] = fw[dd * ULD + ch + e]; wg[dd][e] = fw[dd * ULD + FF + ch + e]; }
    float pa[8], pg[8], ca[8], cg[8], na[8], ng[8];
#define LDROW(tr, AA, GG) do { if (CTX) { _Pragma("unroll") for (int e = 0; e < 8; ++e) { AA[e] = 0.f; GG[e] = 0.f; } \
        _Pragma("unroll") for (int s = 0; s < 4; ++s) { const float* pr = PU + ((size_t)s * 256 + (tr)) * ULD + 256 * (ch >> 7) + (ch & 127);   const f32x4 a0 = *(const f32x4*)pr, a1 = *(const f32x4*)(pr + 4), g0 = *(const f32x4*)(pr + 128), g1 = *(const f32x4*)(pr + 132); \
            _Pragma("unroll") for (int e = 0; e < 4; ++e) { AA[e] += a0[e]; AA[4 + e] += a1[e]; GG[e] += g0[e]; GG[4 + e] += g1[e]; } } } \
      else { const u32x4 xa = *(const u32x4*)(U + (size_t)(tr) * ULD + ch), xg = *(const u32x4*)(U + (size_t)(tr) * ULD + FF + ch); \
            _Pragma("unroll") for (int e = 0; e < 4; ++e) { AA[2 * e] = bf_lo(xa[e]); AA[2 * e + 1] = bf_hi(xa[e]); GG[2 * e] = bf_lo(xg[e]); GG[2 * e + 1] = bf_hi(xg[e]); } } } while (0)
#pragma unroll
    for (int e = 0; e < 8; ++e) { pa[e] = 0.f; pg[e] = 0.f; }
    if (hasp) LDROW(t0 - 1, pa, pg);
    LDROW(t0, ca, cg);
#pragma unroll
    for (int i = 0; i < NR; ++i) {
        const int t = t0 + i; const bool okn = (i < NR - 1) || hasn;
#pragma unroll
        for (int e = 0; e < 8; ++e) { na[e] = 0.f; ng[e] = 0.f; }
        if (okn) LDROW(t + 1, na, ng);
        float ov[8];
#pragma unroll
        for (int e = 0; e < 8; ++e) { const float ua = pa[e] * wa[0][e] + ca[e] * wa[1][e] + na[e] * wa[2][e], ug = pg[e] * wg[0][e] + cg[e] * wg[1][e] + ng[e] * wg[2][e];
            ov[e] = ua * __builtin_amdgcn_rcpf(1.0f + __builtin_amdgcn_exp2f(-1.4426950408889634f * ua)) * ug; }
        u32x4 ow; ow.x = cvt_pk_bf16(ov[0], ov[1]); ow.y = cvt_pk_bf16(ov[2], ov[3]); ow.z = cvt_pk_bf16(ov[4], ov[5]); ow.w = cvt_pk_bf16(ov[6], ov[7]);
        if (CTX) { const unsigned long long w0 = (unsigned long long)ow.x | ((unsigned long long)ow.y << 32), w1 = (unsigned long long)ow.z | ((unsigned long long)ow.w << 32);
            __hip_atomic_store((unsigned long long*)(A + (size_t)t * FF + ch), w0, __ATOMIC_RELAXED, __HIP_MEMORY_SCOPE_AGENT); __hip_atomic_store((unsigned long long*)(A + (size_t)t * FF + ch + 4), w1, __ATOMIC_RELAXED, __HIP_MEMORY_SCOPE_AGENT); }
        else *(u32x4*)(A + (size_t)t * FF + ch) = ow;
#pragma unroll
        for (int e = 0; e < 8; ++e) { pa[e] = ca[e]; pg[e] = cg[e]; ca[e] = na[e]; cg[e] = ng[e]; }
    }
#undef LDROW
}
__device__ __forceinline__ float wave_absmax128(const float* g, int lane) {
    float m = fmaxf(fabsf(g[lane]), fabsf(g[lane + 64]));
#pragma unroll
    for (int o = 1; o < 64; o <<= 1) m = fmaxf(m, __int_as_float(__builtin_amdgcn_ds_bpermute((lane ^ o) << 2, __float_as_int(m))));
    return m;
}
__device__ __forceinline__ float silu_f(float x) { return x / (1.0f + __expf(-x)); }

__global__ void __launch_bounds__(NWAVES * 64, 2) fwd(Args args) {
    extern __shared__ __attribute__((aligned(16))) unsigned char lds_raw[];
    LAS unsigned char* lds = (LAS unsigned char*)lds_raw;
    const int tid0 = threadIdx.x, wave = __builtin_amdgcn_readfirstlane(tid0 >> 6);
    const int G = gridDim.x, bx = blockIdx.x;
#define LAUNDER_TID() int tid = tid0; asm volatile("" : "+v"(tid)); const int lane = tid & 63; (void)lane; unsigned long long wsi_ = (unsigned long long)args.ws, outi_ = (unsigned long long)args.out; int bxr = bx; asm volatile("" : "+s"(wsi_), "+s"(outi_), "+s"(bxr)); unsigned char* ws = (unsigned char*)(GAS unsigned char*)wsi_; float* outp = (float*)(GAS float*)outi_; (void)outp; (void)bxr
    const int gw = bx * NWAVES + wave, NGW = G * NWAVES;
    unsigned* ctl = (unsigned*)(args.ws + WS_CTL);
    for (int u = tid0; u < (LDS_BYTES - LDSCTL_OFF) / 4; u += NWAVES * 64) ((LAS unsigned*)(lds + LDSCTL_OFF))[u] = 0u;
    __syncthreads();
    LAS unsigned long long* ptab = (LAS unsigned long long*)(lds + PTAB_OFF);
    if (tid0 == 0) {
#define PT(i) ptab[i] = (unsigned long long)args.in[i]
        PT(0); PT(1); PT(2); PT(3); PT(4); PT(5); PT(6); PT(7); PT(8); PT(9); PT(10); PT(11); PT(12); PT(13); PT(14); PT(15); PT(16); PT(17); PT(18); PT(19); PT(20); PT(21); PT(22); PT(23); PT(24);
#undef PT
    }
    __syncthreads();
#define INP(i) ((const float*)uptr(ptab, (i)))
#if MK_PER_PHASE
#define GRID_BAR() do { } while (0)
#else
    (void)xcd_barrier_post(ctl + CW_BAR, (volatile LAS unsigned*)(lds + MISC_OFF) + 8);
#define GRID_BAR() do { XcdBarrier bar_; bar_.bar = (unsigned*)(args.ws + WS_CTL) + CW_BAR; bar_.x = xb_xcc_id(); bar_.st = (volatile LAS unsigned*)(lds + MISC_OFF) + 8; xcd_barrier(bar_); } while (0)
#endif
    const int lo = args.ph_lo, hi = args.ph_hi;
#define IN(k) (lo <= (k) && (k) < hi)
#define SEAM(k) do { if (IN((k) + 1)) GRID_BAR(); } while (0)

#define XN ((bf16_t*)(ws + WS_XN))
#define Z ((bf16_t*)(ws + WS_Z))
#define XT ((bf16_t*)(ws + WS_XT))
#define YT ((bf16_t*)(ws + WS_YT))
#define YS ((bf16_t*)(ws + WS_YS))
#define PB ((bf16_t*)(ws + WS_P))
#define HB ((bf16_t*)(ws + WS_HB))
#define MG ((bf16_t*)(ws + WS_MG))
#define ACT ((bf16_t*)(ws + WS_ACT))
#define XTC ((bf16_t*)(ws + WS_XTC))
#define HC ((float*)(ws + WS_HC))
#define MOD ((float*)(ws + WS_MOD))
#define ADAP ((float*)(ws + WS_ADAP))
#define D1 ((bf16_t*)(ws + WS_D1))
#define DCT ((bf16_t*)(ws + WS_DCT))
#define DCTX ((bf16_t*)(ws + WS_DCTX))
#define TW ((f32x2*)(ws + WS_TW))
#define RT ((f32x2*)(ws + WS_RT))
#define CT ((f32x2*)(ws + WS_CT))
#define OUTP (outp)
#define wl (ws + WS_W + (size_t)l * WL_STRIDE)
#define modL ((const float*)(ws + WS_MOD) + (size_t)(l * 2 + 0) * NADA)
#define modC ((const float*)(ws + WS_MOD) + (size_t)(l * 2 + 1) * NADA)
#define hL ((l == 0) ? INP(I_X) : (const float*)outp)
#define hCx ((l == 0) ? INP(I_CTX) : (const float*)HC)

    if (IN(0)) { PROBE_REP(0) { LAUNDER_TID();
        LAS float* sv = (LAS float*)(lds + 98304);
        for (int i = tid; i < 2048; i += NWAVES * 64) { sv[i] = silu_f(INP(I_C)[i]); sv[2048 + i] = silu_f(INP(I_CCTX)[i]); }
        __syncthreads();
        for (int it = gw; it < 4 * 32 * 48; it += NGW) {
            const int l = it / 1536, kc = (it / 48) % 32, cc = it % 48, col = cc * 256 + lane * 4;
            const float* Wp = INP(I_WADA) + ((size_t)l * 2048 + kc * 64) * NADA + col;
            f32x4 a0 = (f32x4){0.f, 0.f, 0.f, 0.f}, a1 = a0;
#pragma unroll 16
            for (int k = 0; k < 64; ++k) { const f32x4 w = *(const f32x4*)(Wp + (size_t)k * NADA); const float s0 = sv[kc * 64 + k], s1 = sv[2048 + kc * 64 + k]; a0 += w * s0; a1 += w * s1; }
            float* pp = ADAP + ((size_t)(l * 32 + kc) * 2) * NADA + col;
            *(f32x4*)pp = a0; *(f32x4*)(pp + NADA) = a1;
        }
        LAS float* scr = (LAS float*)(lds + wave * 8448);
        constexpr int I_IN = 32 * 80, I_GATE = 32 * 128, I_O = 32 * 32, I_UP = 32 * 176, I_DOWN = 88 * 32, I_OC = 8 * 32, I_OG = 16 * 32;
        constexpr int I_LAYER = I_IN + I_GATE + I_O + I_UP + I_DOWN + 3 * I_OC + I_OG;
        for (int it = gw; it < DEPTH * I_LAYER; it += NGW) {
            const int l = it / I_LAYER; int r = it % I_LAYER;
            unsigned char* wlp = ws + WS_W + (size_t)l * WL_STRIDE;
            if (r < I_IN) { const int kb = r / 80, nb = r % 80; const float* W = INP(I_WIN) + (size_t)l * 2048 * NIN;
                if (nb >= 24 && nb < 32) { copy_item(W, NIN, 64 * kb, 64 * nb, (bf16_t*)(wlp + WL_INF), 512, 64 * nb - 1536, lane); copy_item(W, NIN, 64 * kb, 64 * nb + 32, (bf16_t*)(wlp + WL_INF), 512, 64 * nb + 32 - 1536, lane); }
                else transpose_item(W, NIN, 64 * kb, 64 * nb, (bf16_t*)(wlp + WL_IN), 2048, 0, 1, scr, lane);
                continue; } r -= I_IN;
            if (r < I_GATE) { transpose_item(INP(I_WGATE) + (size_t)l * 2048 * 8192, 8192, 64 * (r / 128), 64 * (r % 128), (bf16_t*)(wlp + WL_GATE), 2048, 0, 2, scr, lane); continue; } r -= I_GATE;
            if (r < I_O) { transpose_item(INP(I_WO) + (size_t)l * 2048 * 2048, 2048, 64 * (r / 32), 64 * (r % 32), (bf16_t*)(wlp + WL_O), 2048, 0, 0, scr, lane); continue; } r -= I_O;
            if (r < I_UP) { transpose_item(INP(I_WUP) + (size_t)l * 2048 * ULD, ULD, 64 * (r / 176), 64 * (r % 176), (bf16_t*)(wlp + WL_UP), 2048, 0, 3, scr, lane); continue; } r -= I_UP;
            if (r < I_DOWN) { transpose_item(INP(I_WDOWN) + (size_t)l * FF * 2048, 2048, 64 * (r / 32), 64 * (r % 32), (bf16_t*)(wlp + WL_DOWN), FF, 0, 0, scr, lane); continue; } r -= I_DOWN;
            if (r < I_OC) { transpose_item(INP(I_WCO) + (size_t)l * 512 * 2048, 2048, 64 * (r / 32), 64 * (r % 32), (bf16_t*)(wlp + WL_OUT), YLD, 0, 0, scr, lane); continue; } r -= I_OC;
            if (r < I_OC) { transpose_item(INP(I_WFO) + (size_t)l * 512 * 2048, 2048, 64 * (r / 32), 64 * (r % 32), (bf16_t*)(wlp + WL_OUT), YLD, 512, 0, scr, lane); continue; } r -= I_OC;
            if (r < I_OC) { transpose_item(INP(I_WNO) + (size_t)l * 512 * 2048, 2048, 64 * (r / 32), 64 * (r % 32), (bf16_t*)(wlp + WL_OUT), YLD, 1024, 0, scr, lane); continue; } r -= I_OC;
            transpose_item(INP(I_WGO) + (size_t)l * 1024 * 2048, 2048, 64 * (r / 32), 64 * (r % 32), (bf16_t*)(wlp + WL_OUT), YLD, 1536, 0, scr, lane);
        }
        const int gt = bx * (NWAVES * 64) + tid, NGT = G * NWAVES * 64;
        for (int i = gt; i < 256 * 256; i += NGT) { const int n = i >> 8, k = i & 255, ro = n >> 7, k1 = n & 127, ri = k >> 7, tA = k & 127;
            const float x = (float)((k1 * tA) & 127) * (1.0f / 64.0f); const float cs = cospif(x), sn = sinpif(x);
            const float v = ro == 0 ? (ri == 0 ? cs : sn) : (ri == 0 ? -sn : cs); D1[i] = (bf16_t)(cvt_pk_bf16(v, 0.f) & 0xffffu); }
        for (int i = gt; i < 1024 * 512; i += NGT) { const int m = i >> 9, cf = i & 511, g = m >> 8, ri = (m >> 7) & 1, cp = m & 127, g2 = cf >> 7, c = cf & 127;
            const float x = (float)((cp * c) & 127) * (1.0f / 64.0f); const float v = (g == g2) ? (ri == 0 ? cospif(x) : -sinpif(x)) : 0.f; DCT[i] = (bf16_t)(cvt_pk_bf16(v, 0.f) & 0xffffu); }
        for (int i = gt; i < 256 * 512; i += NGT) { const int k = i >> 9, kk = i & 511, ri = kk >> 8, t = kk & 255;
            const float x = (float)((k * t) & 255) * (1.0f / 128.0f); const float v = ri == 0 ? cospif(x) : sinpif(x); DCTX[i] = (bf16_t)(cvt_pk_bf16(v, 0.f) & 0xffffu); }
        for (int i = gt; i < 128 * 128; i += NGT) { const int k1 = i >> 7, tB = i & 127; const float x = (float)(k1 * tB) * (1.0f / 8192.0f); TW[i] = (f32x2){cospif(x), sinpif(x)}; }
        for (int i = gt; i < 256 * 32 + 64 * 32; i += NGT) { const bool isr = i < 256 * 32; const int ii = isr ? i : i - 256 * 32; const int p = ii >> 5, j = ii & 31;
            const float inv = powf(10000.0f, -(float)j / 32.0f); const float ang = (float)p * inv; float sn, cs; sincosf(ang, &sn, &cs);
            if (isr) RT[ii] = (f32x2){cs, sn}; else CT[ii] = (f32x2){cs, sn}; }
        PROBE_END(); } SEAM(0);
    }
    if (IN(1)) { PROBE_REP(1) { LAUNDER_TID();
        const int gt = bx * (NWAVES * 64) + tid, NGT = G * NWAVES * 64;
        for (int i = gt; i < DEPTH * 2 * NADA; i += NGT) { const int l = i / (2 * NADA), v = (i / NADA) & 1, col = i % NADA;
            float s = INP(I_BADA)[l * NADA + col];
#pragma unroll
            for (int kc = 0; kc < 32; ++kc) s += ADAP[((size_t)(l * 32 + kc) * 2 + v) * NADA + col];
            MOD[i] = s; }
        pg8::ProbFold P{(const char*)DCT, (const char*)(ws + WS_W + WL_INF), 512, 512, 128L * 512 * 2, 128L * 512 * 2, 256L * 512 * 2, 256L * 512 * 2, (long)WL_STRIDE};
        pg8::StaticOrder S; S.init(16, 8, G, bx);
        pg8::EpiPlain E{(bf16_t*)(ws + WS_W + WL_FT), 2048, 0.08838834764831845f, 4, WL_STRIDE / 2};
        pg8::gemm_phase(lds, P, S, E);
        PROBE_END(); } SEAM(1);
    }

    for (int l = 0; l < DEPTH; ++l) {
        const int pb = 2 + 8 * l;
        unsigned* tcnt = (unsigned*)(args.ws + WS_CTL) + CW_TEAM + (size_t)(l * NSTEP) * 65 * 64;
#define TCNT(s, j) (tcnt + ((s) * 65 + (j)) * 64)
        unsigned* ttmo = (unsigned*)(args.ws + WS_CTL) + CW_BAR + XB_TMO;
        const bool lastl = (l == DEPTH - 1);
        const int nPan = lastl ? 64 : 65;

        if (IN(pb + 0)) { LAUNDER_TID();
            const int mypm = 8 * (bxr & 7) + ((bxr >> 3) & 7), myq = (bxr >> 6) & 3;
            { const bool hv = (l != 0); norm_lat_rows(l == 0 ? (const void*)INP(I_X) : (const void*)HB, l != 0, 256 * mypm + 64 * myq + (hv ? 9 : 8) * wave, hv ? (wave < 7 ? 9 : 1) : 8, INP(I_NORM1) + l * D, modL, 0, XN, lane); }
            if (wave == 7 && bxr < CTXL) norm_ctx_row(bx, hCx, (const float*)(ws + WS_PDN), l == 0 ? 0 : 11, MOD + (size_t)((l - 1) * 2 + 1) * NADA + 5 * D, HC, INP(I_NORM1) + l * D, modC, 0, XN, lane);
            team_arrive(tcnt + (0 * 65 + mypm) * 64, tcnt + (0 * 65 + 64) * 64);
            team_wait(tcnt + (0 * 65 + mypm) * 64, 4u, ttmo);
            { pg8::ProbPlain P{(const char*)XN, (const char*)(wl + WL_IN), 2048, 2048, 128L * 2048 * 2, 128L * 2048 * 2, 256L * 2048 * 2, 256L * 2048 * 2, 32};
              pg8::StaticOrder S; S.init(64, 18, G, bx);
              pg8::EpiZ E{Z, INP(I_NAQG) + l * 128, INP(I_NAKG) + l * 128, INP(I_GQG) + l * 128, INP(I_GKG) + l * 128, RT, CT, (LAS float*)(lds + HALO_OFF), 0};
              pg8::gemm_phase(lds, P, S, E); }
            team_wait(tcnt + (0 * 65 + 64) * 64, (unsigned)G, ttmo);
            {
              pg8::ProbPlain P{(const char*)(wl + WL_FT), (const char*)XN, 2048, 128 * 2048, 128L * 2048 * 2, 2048L * 2, 256L * 2048 * 2, 2L * 2048 * 2, 32};
              pg8::StaticOrder S; S.init(4, 64, G, (bxr + 104) % G); pg8::EpiF0 E{XT};
              pg8::gemm_phase(lds, P, S, E); }
            {
              pg8::ProbPlain P{(const char*)(XN + (size_t)SEQ * D), (const char*)(wl + WL_IN), 2048, 2048, 128L * 2048 * 2, 128L * 2048 * 2, 256L * 2048 * 2, 256L * 2048 * 2, 32};
              pg8::StaticOrder S; S.init(1, 18, G, (bxr + 92) % G);
              pg8::EpiZ E{Z + (size_t)SEQ * ZLD, INP(I_NAQG) + l * 128, INP(I_NAKG) + l * 128, INP(I_GQG) + l * 128, INP(I_GKG) + l * 128, RT, CT, (LAS float*)(lds + HALO_OFF), 1};
              pg8::gemm_phase(lds, P, S, E); }
            if (!lastl) {
              pg8::ProbPlain P{(const char*)(wl + WL_FT), (const char*)(XN + (size_t)SEQ * D), 2048, 2048, 128L * 2048 * 2, 128L * 2048 * 2, 256L * 2048 * 2, 256L * 2048 * 2, 32};
              pg8::StaticOrder S; S.init(4, 1, G, (bxr + 128) % G); pg8::EpiF0c E{XTC};
              pg8::gemm_phase(lds, P, S, E); }
            if (!lastl) {
              pg8::ProbPlain P{(const char*)(XN + (size_t)SEQ * D), (const char*)(wl + WL_GATE), 2048, 2048, 128L * 2048 * 2, 128L * 2048 * 2, 256L * 2048 * 2, 256L * 2048 * 2, 32};
              pg8::StaticOrder S; S.init(1, 32, G, (bxr + 124) % G); pg8::EpiPlain1 E{(bf16_t*)(ws + WS_GC), 8192, 1.0f, 0, 0};
              pg8::gemm_phase(lds, P, S, E); }
            SEAM(pb + 0);
        }
        if (IN(pb + 1)) { PROBE_REP(4) { LAUNDER_TID();
            const float* cw = INP(I_CONVW) + l * 3 * 512;
            const bool f1c_wg = !lastl && (bxr == 240 || bxr == 241);
            const int cgw = (bxr < 240 || lastl) ? gw : gw - 2 * NWAVES, cngw = lastl ? NGW : NGW - 2 * NWAVES;
            f32x4 cwt[3][2];
#pragma unroll
            for (int dd = 0; dd < 3; ++dd) { cwt[dd][0] = *(const f32x4*)(cw + dd * 512 + 8 * lane); cwt[dd][1] = *(const f32x4*)(cw + dd * 512 + 8 * lane + 4); }
            for (int r = f1c_wg ? MT : cgw; r < MT; r += cngw) {
                bf16_t* zr = (rep_ == 0 ? Z : PB) + (size_t)r * ZLD;     const bool lat = r < SEQ; const int grow = (r >> 6) & 255, gcol = r & 63; const int q = lane & 15;
                const bool hasp = (r != 0) && (r != SEQ), hasn = (r != SEQ - 1) && (r != MT - 1);
                const int ch = 8 * lane; float cx[3][8];
#pragma unroll
                for (int dd = 0; dd < 3; ++dd) {
                    const bool ok = dd == 1 || (dd == 0 ? hasp : hasn);
                    u32x4 xa = (u32x4){0u, 0u, 0u, 0u}, cg = xa;
                    if (ok) { const bf16_t* zz = zr + (long)(dd - 1) * ZLD; xa = *(const u32x4*)(zz + ch); cg = *(const u32x4*)(zz + 1024 + ch); }
#pragma unroll
                    for (int e = 0; e < 4; ++e) { cx[dd][2 * e] = bf_lo(xa[e]) * bf_lo(cg[e]); cx[dd][2 * e + 1] = bf_hi(xa[e]) * bf_hi(cg[e]); }
                }
                const u32x4 bgw = *(const u32x4*)(zr + 512 + ch); float ov[8];
#pragma unroll
                for (int e = 0; e < 8; ++e) { const float bgv = (e & 1) ? bf_hi(bgw[e >> 1]) : bf_lo(bgw[e >> 1]);
                    ov[e] = bgv * (cx[0][e] * cwt[0][e >> 2][e & 3] + cx[1][e] * cwt[1][e >> 2][e & 3] + cx[2][e] * cwt[2][e >> 2][e & 3]); }
                u32x4 ow; ow.x = cvt_pk_bf16(ov[0], ov[1]); ow.y = cvt_pk_bf16(ov[2], ov[3]); ow.z = cvt_pk_bf16(ov[4], ov[5]); ow.w = cvt_pk_bf16(ov[6], ov[7]);
                *(u32x4*)(YS + (size_t)r * YLD + ch) = ow;
            }
            __syncthreads();
            { pg8::ProbPlain P{(const char*)D1, (const char*)XT, 256, 256, 128L * 256 * 2, 128L * 256 * 2, 256L * 256 * 2, 256L * 256 * 2, 4};
              pg8::StaticOrder S; S.init(1, 256, G, bx); pg8::EpiF1s E{YT, TW, 0.08838834764831845f};
              pg8::gemm_phase(lds, P, S, E); }
            if (!lastl) {
              pg8::ProbPlain P{(const char*)DCTX, (const char*)XTC, 512, 512, 128L * 512 * 2, 128L * 512 * 2, 256L * 512 * 2, 256L * 512 * 2, 8};
              pg8::StaticOrder S; S.init(1, 2, G, (bxr + 16) % G); pg8::EpiF1cs E{YS, 0.0625f};
              pg8::gemm_phase(lds, P, S, E); }
            PROBE_END(); } SEAM(pb + 1);
        }
        if (IN(pb + 2)) { PROBE_REP(5) { LAUNDER_TID();
            { pg8::ProbPlain P{(const char*)D1, (const char*)YT, 256, 256, 128L * 256 * 2, 128L * 256 * 2, 256L * 256 * 2, 256L * 256 * 2, 4};
              pg8::StaticOrder S; S.init(1, 256, G, bx); pg8::EpiF2s E{YS, 0.08838834764831845f};
              pg8::gemm_phase(lds, P, S, E); }
            __syncthreads();
            const float kC = att::SCALE * 1.4426950408889634f;
            const float qkb_g = __uint_as_float(__builtin_amdgcn_readfirstlane(__float_as_uint(129.3f * wave_absmax128(INP(I_GQG) + l * 128, lane) * wave_absmax128(INP(I_GKG) + l * 128, lane))));
            const float qkb_n = __uint_as_float(__builtin_amdgcn_readfirstlane(__float_as_uint(129.3f * wave_absmax128(INP(I_NAQG) + l * 128, lane) * wave_absmax128(INP(I_NAKG) + l * 128, lane))));
            const int ndense = lastl ? 512 : 524;
            for (int u = bx; u < ndense; u += G) {
                const bf16_t *Qp, *Kp, *Vp; bf16_t* Op; int NT;
                if (u < 512) { const int idx = u & 255, h = 4 * (u >> 8) + (idx & 3), qb = idx >> 2;
                    Qp = Z + (size_t)qb * 256 * ZLD + 3072 + h * 128; Kp = Z + 4096 + (h >> 2) * 128; Vp = Z + 4352 + (h >> 2) * 128; Op = YS + (size_t)qb * 256 * YLD + 1536 + h * 128; NT = MT / 64; }
                else if (u < 520) { const int h = u - 512; const bf16_t* zc = Z + (size_t)SEQ * ZLD;
                    Qp = zc + 3072 + h * 128; Kp = zc + 4096 + (h >> 2) * 128; Vp = zc + 4352 + (h >> 2) * 128; Op = YS + (size_t)SEQ * YLD + 1536 + h * 128; NT = 4; }
                else { const int h = u - 520; const bf16_t* zc = Z + (size_t)SEQ * ZLD;
                    Qp = zc + 1536 + h * 128; Kp = zc + 2048 + h * 128; Vp = zc + 2560 + h * 128; Op = YS + (size_t)SEQ * YLD + 1024 + h * 128; NT = 4; }
                att::attn_body(Qp, Kp, Vp, Op, NT, ZLD, ZLD, YLD, (char*)lds_raw, -(u < 520 ? qkb_g : qkb_n) * kC);
            }
            for (int u = bx; u < 256; u += G) {
                const int h = u & 3, qb = u >> 2; const int r0 = 4 * qb, nlo = min(max(r0 - 4, 0), 244);
                att::attn_na(Z + (size_t)qb * 256 * ZLD + 1536 + h * 128, Z + 2048 + h * 128, Z + 2560 + h * 128, YS + (size_t)qb * 256 * YLD + 1024 + h * 128,
                             ZLD, ZLD, YLD, (char*)lds_raw, nlo, r0, INP(I_RPB) + (size_t)(l * 4 + h) * 465, qkb_n);
            }
            PROBE_END(); } SEAM(pb + 2);
        }
        if (IN(pb + 3)) { PROBE_REP(6) { LAUNDER_TID();
            pg8::ProbOut P{(const char*)YS, (const char*)(wl + WL_OUT), YLD, YLD, 128L * YLD * 2, 128L * YLD * 2, 256L * YLD * 2, 256L * YLD * 2};
            pg8::StaticOrder S; S.init(nPan, 32, G, bx); pg8::EpiPlain1 E{PB, PLD, 1.0f, 0, 0};
            pg8::gemm_phase(lds, P, S, E);
            PROBE_END(); } SEAM(pb + 3);
        }
        if (IN(pb + 4)) { PROBE_REP(7) { LAUNDER_TID();
            pg8::ProbPlain P{(const char*)XN, (const char*)(wl + WL_GATE), 2048, 2048, 128L * 2048 * 2, 128L * 2048 * 2, 256L * 2048 * 2, 256L * 2048 * 2, 32};
            if (!lastl) {
                const float* bg = INP(I_BGATE) + (size_t)l * 8192; const bf16_t* gc = (const bf16_t*)(ws + WS_GC);
                for (int i = bx * (NWAVES * 64) + tid; i < 256 * 256; i += G * NWAVES * 64) { const int row = i >> 8, d0 = (i & 255) * 8; float s[8];
#pragma unroll
                    for (int e = 0; e < 8; ++e) s[e] = 0.f;
#pragma unroll
                    for (int b = 0; b < 4; ++b) { const u32x4 gw4 = *(const u32x4*)(gc + (size_t)row * 8192 + rowmap(2, b * 2048 + d0)), pw4 = *(const u32x4*)(PB + (size_t)(SEQ + row) * PLD + b * 2048 + d0);
#pragma unroll
                        for (int e = 0; e < 8; ++e) { const float x = ((e & 1) ? bf_hi(gw4[e >> 1]) : bf_lo(gw4[e >> 1])) + GATE_PRESCALE * bg[b * 2048 + d0 + e], pv = (e & 1) ? bf_hi(pw4[e >> 1]) : bf_lo(pw4[e >> 1]);
                            s[e] += __builtin_amdgcn_rcpf(1.0f + __builtin_amdgcn_exp2f(x)) * pv; } }
                    u32x4 o; o.x = cvt_pk_bf16(s[0], s[1]); o.y = cvt_pk_bf16(s[2], s[3]); o.z = cvt_pk_bf16(s[4], s[5]); o.w = cvt_pk_bf16(s[6], s[7]);
                    *(u32x4*)(MG + (size_t)(SEQ + row) * D + d0) = o; }
            }
            pg8::StaticOrder S; S.init(64, 32, G, bx); pg8::EpiGate E{PB, INP(I_BGATE) + (size_t)l * 8192, MG};
            pg8::gemm_phase(lds, P, S, E);
            PROBE_END(); } SEAM(pb + 4);
        }
        if (IN(pb + 5)) { PROBE_REP(8) { LAUNDER_TID();
            pg8::ProbPlain P{(const char*)MG, (const char*)(wl + WL_O), 2048, 2048, 128L * 2048 * 2, 128L * 2048 * 2, 256L * 2048 * 2, 256L * 2048 * 2, 32};
            { pg8::StaticOrder S; S.init(64, 8, G, bx); pg8::EpiResid E{l == 0 ? (const void*)INP(I_X) : (const void*)HB, HB, modL + 2 * D, l != 0, 1};
              pg8::gemm_phase(lds, P, S, E); }
            if (!lastl) {
              pg8::ProbPlain Pc{(const char*)(MG + (size_t)SEQ * D), (const char*)(wl + WL_O), 2048, 2048, 128L * 2048 * 2, 128L * 2048 * 2, 256L * 2, 256L * 2048 * 2, 4, 256L * 2};
              pg8::StaticOrder S; S.init(8, 8, G, bx); pg8::EpiF32 E{(float*)(ws + WS_PWO), D, (size_t)256 * D};
              pg8::gemm_phase(lds, Pc, S, E); }
            PROBE_END(); } SEAM(pb + 5);
        }
        if (IN(pb + 6)) { LAUNDER_TID();
            const int mypm = 8 * (bxr & 7) + ((bxr >> 3) & 7), myq = (bxr >> 6) & 3;
            { const bool hv = !lastl; norm_lat_rows(HB, 1, 256 * mypm + 64 * myq + (hv ? 9 : 8) * wave, hv ? (wave < 7 ? 9 : 1) : 8, INP(I_NORM2) + l * D, modL, 3 * D, XN, lane); }
            if (!lastl && wave == 7 && bxr < CTXL) norm_ctx_row(bx, hCx, (const float*)(ws + WS_PWO), 8, modC + 2 * D, HC, INP(I_NORM2) + l * D, modC, 3 * D, XN, lane);
            team_arrive(tcnt + (1 * 65 + mypm) * 64, tcnt + (1 * 65 + 64) * 64);
            team_wait(tcnt + (1 * 65 + mypm) * 64, 4u, ttmo);
            pg8::ProbPlain P{(const char*)XN, (const char*)(wl + WL_UP), 2048, 2048, 128L * 2048 * 2, 128L * 2048 * 2, 256L * 2048 * 2, 256L * 2048 * 2, 32};
            { pg8::StaticOrder S; S.init(64, 44, G, bx); pg8::EpiUpConv E{ACT, (float*)(ws + WS_SB), INP(I_FCW) + (size_t)l * 3 * ULD, (LAS float*)(lds + HALO_OFF)};
              pg8::gemm_phase(lds, P, S, E); }
            if (!lastl) {
              team_wait(tcnt + (1 * 65 + 64) * 64, (unsigned)G, ttmo);
              pg8::ProbPlain Pc{(const char*)(XN + (size_t)SEQ * D), (const char*)(wl + WL_UP), 2048, 2048, 128L * 2048 * 2, 128L * 2048 * 2, 512L * 2, 256L * 2048 * 2, 8, 512L * 2};
              pg8::StaticOrder S; S.init(4, 44, G, bx); pg8::EpiF32 E{(float*)(ws + WS_PUP), ULD, (size_t)256 * ULD};
              pg8::gemm_phase(lds, Pc, S, E); }
            SEAM(pb + 6);
        }
        if (IN(pb + 7)) { LAUNDER_TID();
            const int mypm = 8 * (bxr & 7) + ((bxr >> 3) & 7), myq = (bxr >> 6) & 3;
            const float* fw = INP(I_FCW) + (size_t)l * 3 * ULD;
            {
              const float* sb = (const float*)(ws + WS_SB);
              for (int i = tid; i < 2 * 704; i += NWAVES * 64) { const int which = i / 704, cp = (i % 704) * 2 + myq * 1408;
                  const int pc = 256 * (cp >> 7) + (cp & 127);
                  const float* r0 = which == 0 ? (mypm > 0 ? sb + ((size_t)(mypm - 1) * 4 + 3) * ULD : nullptr) : sb + ((size_t)mypm * 4 + 2) * ULD;
                  const float* r1 = sb + ((size_t)mypm * 4 + (which == 0 ? 0 : 3)) * ULD;
                  const float* r2 = which == 0 ? sb + ((size_t)mypm * 4 + 1) * ULD : (mypm < 63 ? sb + ((size_t)(mypm + 1) * 4 + 0) * ULD : nullptr);
                  float o[2];
#pragma unroll
                  for (int e = 0; e < 2; ++e) { const float a0 = r0 ? r0[pc + e] : 0.f, a1 = r1[pc + e], a2 = r2 ? r2[pc + e] : 0.f, g0 = r0 ? r0[pc + 128 + e] : 0.f, g1 = r1[pc + 128 + e], g2 = r2 ? r2[pc + 128 + e] : 0.f;
                      const float ua = a0 * fw[cp + e] + a1 * fw[ULD + cp + e] + a2 * fw[2 * ULD + cp + e], ug = g0 * fw[FF + cp + e] + g1 * fw[ULD + FF + cp + e] + g2 * fw[2 * ULD + FF + cp + e];
                      o[e] = ua * __builtin_amdgcn_rcpf(1.0f + __builtin_amdgcn_exp2f(-1.4426950408889634f * ua)) * ug; }
                  __hip_atomic_store((unsigned*)(ACT + (size_t)(256 * mypm + (which == 0 ? 0 : 255)) * FF + cp), cvt_pk_bf16(o[0], o[1]), __ATOMIC_RELAXED, __HIP_MEMORY_SCOPE_AGENT); } }
            if (!lastl)
                for (int it = gw; it < 11 * 64; it += NGW) { const int cc = it % 11, rb = it / 11, t0 = rb * 4;
                    ffn_conv_rows<true, 4>(nullptr, (const float*)(ws + WS_PUP), fw, ACT + (size_t)SEQ * FF, t0, cc * 512 + 8 * lane, t0 != 0, t0 + 4 != CTXL); }
            team_arrive(TCNT(ST_CONV, mypm), TCNT(ST_CONV, 64));
            team_wait(TCNT(ST_CONV, mypm), 4u, ttmo);
            pg8::ProbPlain P{(const char*)ACT, (const char*)(wl + WL_DOWN), FF, FF, 128L * FF * 2, 128L * FF * 2, 256L * FF * 2, 256L * FF * 2, 88};
            { pg8::StaticOrder S; S.init(64, 8, G, bx); pg8::EpiResid E{HB, lastl ? (void*)OUTP : (void*)HB, modL + 5 * D, 1, lastl ? 0 : 1};
              pg8::gemm_phase(lds, P, S, E); }
            if (!lastl) {
              team_wait(TCNT(ST_CONV, 64), (unsigned)G, ttmo);
              pg8::ProbPlain Pc{(const char*)(ACT + (size_t)SEQ * FF), (const char*)(wl + WL_DOWN), FF, FF, 128L * FF * 2, 128L * FF * 2, 512L * 2, 256L * FF * 2, 8, 512L * 2};
              pg8::StaticOrder S; S.init(11, 8, G, bx); pg8::EpiF32 E{(float*)(ws + WS_PDN), D, (size_t)256 * D};
              pg8::gemm_phase(lds, Pc, S, E); }
            SEAM(pb + 7);
        }
    }
#undef XN
#undef Z
#undef XT
#undef YT
#undef YS
#undef PB
#undef HB
#undef MG
#undef ACT
#undef XTC
#undef HC
#undef MOD
#undef ADAP
#undef D1
#undef DCT
#undef DCTX
#undef TW
#undef RT
#undef CT
#undef OUTP
#undef wl
#undef modL
#undef modC
#undef hL
#undef hCx
#undef TCNT
#undef IN
#undef SEAM
#undef GRID_BAR
#undef INP
}

constexpr int N_PHASES = 2 + 8 * DEPTH;

extern "C" void kernel_launch(void* const* d_in, const int* in_sizes, int n_in, void* d_out, int out_size, void* d_ws, size_t ws_size, hipStream_t stream) {
    static int grid = 0;
    if (grid == 0) {
        if (n_in != 25 || out_size != SEQ * D || ws_size < WS_END) { fprintf(stderr, "kernel_launch: unexpected shapes (n_in %d out %d ws %zu need %zu)\n", n_in, out_size, ws_size, (size_t)WS_END); grid = -1; return; }
        int dev = 0, cus = 0;
        if (hipGetDevice(&dev) != hipSuccess || hipDeviceGetAttribute(&cus, hipDeviceAttributeMultiprocessorCount, dev) != hipSuccess) { grid = -1; return; }
        if (hipFuncSetAttribute((const void*)fwd, hipFuncAttributeMaxDynamicSharedMemorySize, LDS_BYTES) != hipSuccess) { fprintf(stderr, "kernel_launch: hipFuncSetAttribute failed\n"); grid = -1; return; }
        int per_cu = 0;
        if (hipOccupancyMaxActiveBlocksPerMultiprocessor(&per_cu, (const void*)fwd, NWAVES * 64, LDS_BYTES) != hipSuccess || per_cu < 1) fprintf(stderr, "kernel_launch: occupancy query reports %d\n", per_cu);
        (void)hipGetLastError();
        grid = cus;
    }
    if (grid < 0) return;
    if (hipMemsetAsync((char*)d_ws + WS_CTL, 0, CTL_ZERO_BYTES, stream) != hipSuccess) return;
    Args a{};
    for (int i = 0; i < 25; ++i) a.in[i] = (const float*)d_in[i];
    a.out = (float*)d_out; a.ws = (unsigned char*)d_ws;
#if MK_PER_PHASE
    for (int p = 0; p < N_PHASES; ++p) { a.ph_lo = p; a.ph_hi = p + 1; hipLaunchKernelGGL(fwd, dim3(grid), dim3(NWAVES * 64), LDS_BYTES, stream, a); }
#else
    a.ph_lo = 0; a.ph_hi = N_PHASES; hipLaunchKernelGGL(fwd, dim3(grid), dim3(NWAVES * 64), LDS_BYTES, stream, a);
#endif
    const hipError_t le = hipPeekAtLastError();
    if (le != hipSuccess) fprintf(stderr, "kernel_launch: launch failed: %s\n", hipGetErrorName(le));
}
```
